# Optimizing an MI355X kernel written in HIP

```python
import jax, jax.numpy as jnp
from jax import lax
import numpy as np

D_MODEL = 2048
BATCH = 4
SEQ = 4096
DEPTH = 2

CTX_LEN = 256
GRID_W = 64
N_DIR = 2
MIX_WIDTH = D_MODEL
GLA_HEADS = 4
GLA_WIDTH = MIX_WIDTH // 2
GLA_DV = GLA_WIDTH // GLA_HEADS
GLA_DK = GLA_DV // 2
GLA_LR = 16
GLA_NORMALIZER = 16.0
MLSTM_HEADS = 4
MLSTM_WIDTH = MIX_WIDTH - GLA_WIDTH
MLSTM_DV = MLSTM_WIDTH // MLSTM_HEADS
MLSTM_DK = MLSTM_DV // 2
CHUNK = 64
D_FF = 128 * ((8 * D_MODEL // 3 + 127) // 128)
CONV_K = 3
EPS = 1e-6

PROJ_SIZES = (GLA_HEADS * GLA_DK, GLA_HEADS * GLA_DK, GLA_WIDTH, GLA_WIDTH, GLA_LR,
              MLSTM_HEADS * MLSTM_DK, MLSTM_HEADS * MLSTM_DK, MLSTM_WIDTH, MLSTM_WIDTH,
              N_DIR * 2 * MLSTM_HEADS)
PROJ_WIDTH = sum(PROJ_SIZES)
PROJ_SPLITS = tuple(int(s) for s in np.cumsum(PROJ_SIZES)[:-1])

kernel_name = 'hymba_gla_mlstm_convffn_prefix_block'


def rmsnorm(x, g):
    xf = x.astype(jnp.float32)
    y = xf * lax.rsqrt(jnp.mean(jnp.square(xf), axis=-1, keepdims=True) + EPS)
    return (y * g.astype(jnp.float32)).astype(x.dtype)


def _rev(t, d):
    return jnp.flip(t, axis=1) if d == 1 else t


def _chunk(t):
    b, t_len = t.shape[:2]
    t = t.reshape((b, t_len // CHUNK, CHUNK) + t.shape[2:])
    return jnp.swapaxes(jnp.moveaxis(t, 1, 0), 2, 3)


def _unchunk(t):
    n, b, h, c, d = t.shape
    return jnp.moveaxis(jnp.swapaxes(t, 2, 3), 0, 1).reshape(b, n * c, h, d)


def gla_scan(k, v, log_a, s0, q=None):
    tril = jnp.tril(jnp.ones((CHUNK, CHUNK), dtype=bool))
    xs = (_chunk(k), _chunk(v), _chunk(log_a)) + ((_chunk(q),) if q is not None else ())

    def step(s, inp):
        kc, vc, ac = inp[:3]
        bcum = jnp.cumsum(ac, axis=2)
        b_end = bcum[:, :, -1, :]
        k_to_end = kc * jnp.exp(b_end[:, :, None, :] - bcum)
        s_new = jnp.exp(b_end)[..., None] * s + jnp.einsum('bhik,bhiv->bhkv', k_to_end, vc)
        if q is None:
            return s_new, None
        qc = inp[3]
        rel = jnp.where(tril[:, :, None], bcum[:, :, :, None, :] - bcum[:, :, None, :, :], -jnp.inf)
        scores = jnp.einsum('bhjk,bhik,bhjik->bhji', qc, kc, jnp.exp(rel))
        o = (jnp.einsum('bhji,bhiv->bhjv', scores, vc)
             + jnp.einsum('bhjk,bhkv->bhjv', qc * jnp.exp(bcum), s))
        return s_new, o

    s_fin, o = lax.scan(step, s0, xs)
    return s_fin, (None if q is None else _unchunk(o))


def mlstm_scan(k, v, log_i, log_f, state0, q=None):
    tril = jnp.tril(jnp.ones((CHUNK, CHUNK), dtype=bool))
    xs = (_chunk(k), _chunk(v), _chunk(log_i), _chunk(log_f)) + ((_chunk(q),) if q is not None else ())

    def step(carry, inp):
        c, n, m = carry
        kc, vc, ic, fc = inp[:4]
        fcum = jnp.cumsum(fc, axis=-1)
        f_end = fcum[..., -1]
        w_log = f_end[..., None] - fcum + ic
        m_new = jnp.maximum(f_end + m, jnp.max(w_log, axis=-1))
        carry_scale = jnp.exp(f_end + m - m_new)
        w = jnp.exp(w_log - m_new[..., None])
        c_new = carry_scale[..., None, None] * c + jnp.einsum('bhi,bhik,bhiv->bhkv', w, kc, vc)
        n_new = carry_scale[..., None] * n + jnp.einsum('bhi,bhik->bhk', w, kc)
        if q is None:
            return (c_new, n_new, m_new), None
        qc = inp[4]
        d_log = jnp.where(tril, fcum[..., :, None] - fcum[..., None, :] + ic[..., None, :], -jnp.inf)
        inter_log = fcum + m[..., None]
        m_q = jnp.maximum(inter_log, jnp.max(d_log, axis=-1))
        s = jnp.einsum('bhjk,bhik->bhji', qc, kc) * jnp.exp(d_log - m_q[..., None])
        inter = jnp.exp(inter_log - m_q)
        num = (jnp.einsum('bhji,bhiv->bhjv', s, vc)
               + inter[..., None] * jnp.einsum('bhjk,bhkv->bhjv', qc, c))
        den = jnp.sum(s, axis=-1) + inter * jnp.einsum('bhjk,bhk->bhj', qc, n)
        h = num / jnp.maximum(jnp.abs(den), jnp.exp(-m_q))[..., None]
        return (c_new, n_new, m_new), h

    st_fin, h = lax.scan(step, state0, xs)
    return st_fin, (None if q is None else _unchunk(h))


def project_heads(h, w_in, gla_w_lr, gla_b_lr, mlstm_b_gate):
    b, t, _ = h.shape
    f32 = jnp.float32
    z = jnp.einsum('btd,dp->btp', h, w_in)
    gq, gk, gv, gg, glr, mq, mk, mv, mo, mgate = jnp.split(z, PROJ_SPLITS, axis=-1)
    gla_q = gq.reshape(b, t, GLA_HEADS, GLA_DK).astype(f32) * (GLA_DK ** -0.5)
    gla_k = gk.reshape(b, t, GLA_HEADS, GLA_DK).astype(f32)
    gla_v = gv.reshape(b, t, GLA_HEADS, GLA_DV).astype(f32)
    gla_gate = gg.reshape(b, t, GLA_HEADS, GLA_DV)
    dec = jnp.einsum('btr,zrk->zbtk', glr, gla_w_lr) + gla_b_lr[:, None, None, :]
    gla_loga = (jax.nn.log_sigmoid(dec.astype(f32)) / GLA_NORMALIZER).reshape(N_DIR, b, t, GLA_HEADS, GLA_DK)
    ml_q = mq.reshape(b, t, MLSTM_HEADS, MLSTM_DK).astype(f32)
    ml_k = mk.reshape(b, t, MLSTM_HEADS, MLSTM_DK).astype(f32) * (MLSTM_DK ** -0.5)
    ml_v = mv.reshape(b, t, MLSTM_HEADS, MLSTM_DV).astype(f32)
    ml_ogate = mo.reshape(b, t, MLSTM_HEADS, MLSTM_DV)
    pre = (mgate.reshape(b, t, N_DIR, 2, MLSTM_HEADS) + mlstm_b_gate).astype(f32)
    ml_logi = jnp.moveaxis(pre[:, :, :, 0], 2, 0)
    ml_logf = jnp.moveaxis(jax.nn.log_sigmoid(pre[:, :, :, 1]), 2, 0)
    scan_in = (gla_q, gla_k, gla_v, gla_loga, ml_q, ml_k, ml_v, ml_logi, ml_logf)
    return scan_in, (gla_gate, ml_ogate)


def recurrent_groups(lat, ctx, with_ctx_out):
    gq, gk, gv, ga, mq, mk, mv, mi, mf = lat
    cq, ck, cv, ca, cmq, cmk, cmv, cmi, cmf = ctx
    b = gq.shape[0]
    f32 = jnp.float32
    gla_lat, ml_lat, gla_ctx, ml_ctx = [], [], [], []
    for d in range(N_DIR):
        s0 = jnp.zeros((b, GLA_HEADS, GLA_DK, GLA_DV), f32)
        s_ctx, o_ctx = gla_scan(_rev(ck, d), _rev(cv, d), _rev(ca[d], d), s0,
                                _rev(cq, d) if with_ctx_out else None)
        _, o_lat = gla_scan(_rev(gk, d), _rev(gv, d), _rev(ga[d], d), s_ctx, _rev(gq, d))
        gla_lat.append(_rev(o_lat, d))
        st0 = (jnp.zeros((b, MLSTM_HEADS, MLSTM_DK, MLSTM_DV), f32),
               jnp.zeros((b, MLSTM_HEADS, MLSTM_DK), f32),
               jnp.zeros((b, MLSTM_HEADS), f32))
        st_ctx, h_ctx = mlstm_scan(_rev(cmk, d), _rev(cmv, d), _rev(cmi[d], d), _rev(cmf[d], d), st0,
                                   _rev(cmq, d) if with_ctx_out else None)
        _, h_lat = mlstm_scan(_rev(mk, d), _rev(mv, d), _rev(mi[d], d), _rev(mf[d], d), st_ctx, _rev(mq, d))
        ml_lat.append(_rev(h_lat, d))
        if with_ctx_out:
            gla_ctx.append(_rev(o_ctx, d))
            ml_ctx.append(_rev(h_ctx, d))
    lat_out = (gla_lat[0] + gla_lat[1], ml_lat[0] + ml_lat[1])
    ctx_out = (gla_ctx[0] + gla_ctx[1], ml_ctx[0] + ml_ctx[1]) if with_ctx_out else None
    return lat_out, ctx_out


def merge_groups(gla_o, ml_h, gla_gate, ml_ogate, gla_g_norm, mlstm_g_norm, w_out, dtype):
    b, t = gla_o.shape[:2]
    f32 = jnp.float32
    y_gla = rmsnorm(gla_o, gla_g_norm) * jax.nn.silu(gla_gate.astype(f32))
    y_ml = jax.nn.sigmoid(ml_ogate.astype(f32)) * rmsnorm(ml_h, mlstm_g_norm)
    y = jnp.concatenate([y_gla.reshape(b, t, GLA_WIDTH), y_ml.reshape(b, t, MLSTM_WIDTH)], axis=-1)
    return jnp.einsum('btm,md->btd', y.astype(dtype), w_out)


def conv_ffn(h, rows, cols, w_up, conv_w, conv_b, w_down):
    b, t, _ = h.shape
    u = jnp.einsum('btd,df->btf', h, w_up)
    u_gate, u_val = jnp.split(u, 2, axis=-1)
    g = lax.conv_general_dilated(u_gate.reshape(b, rows, cols, D_FF), conv_w[:, :, None, :],
                                 window_strides=(1, 1), padding='SAME',
                                 dimension_numbers=('NHWC', 'HWIO', 'NHWC'),
                                 feature_group_count=D_FF)
    g = g.reshape(b, t, D_FF) + conv_b
    return jnp.einsum('btf,fd->btd', jax.nn.silu(g) * u_val, w_down)


def trunk_layer(x, ctx, c_act, cc_act, w_mod, b_mod, g_norm1, g_norm2, w_in, gla_w_lr, gla_b_lr,
                mlstm_b_gate, gla_g_norm, mlstm_g_norm, w_out, w_up, conv_w, conv_b, w_down, update_ctx):
    b, t, _ = x.shape
    rows = t // GRID_W
    mod = (c_act @ w_mod + b_mod)[:, None, :]
    mod_c = (cc_act @ w_mod + b_mod)[None, None, :]
    sh1, sc1, gt1, sh2, sc2, gt2 = jnp.split(mod, 6, axis=-1)
    csh1, csc1, cgt1, csh2, csc2, cgt2 = jnp.split(mod_c, 6, axis=-1)

    h = rmsnorm(x, g_norm1) * (1 + sc1) + sh1
    hc = rmsnorm(ctx, g_norm1) * (1 + csc1) + csh1
    lat_in, lat_gates = project_heads(h, w_in, gla_w_lr, gla_b_lr, mlstm_b_gate)
    ctx_in, ctx_gates = project_heads(hc, w_in, gla_w_lr, gla_b_lr, mlstm_b_gate)
    (lat_gla, lat_ml), ctx_out = recurrent_groups(lat_in, ctx_in, update_ctx)
    x = x + gt1 * merge_groups(lat_gla, lat_ml, lat_gates[0], lat_gates[1],
                               gla_g_norm, mlstm_g_norm, w_out, x.dtype)

    h2 = rmsnorm(x, g_norm2) * (1 + sc2) + sh2
    x = x + gt2 * conv_ffn(h2, rows, GRID_W, w_up, conv_w, conv_b, w_down)

    if update_ctx:
        ctx = ctx + cgt1 * merge_groups(ctx_out[0], ctx_out[1], ctx_gates[0], ctx_gates[1],
                                        gla_g_norm, mlstm_g_norm, w_out, ctx.dtype)
        hc2 = rmsnorm(ctx, g_norm2) * (1 + csc2) + csh2
        ctx = ctx + cgt2 * conv_ffn(hc2, 1, ctx.shape[1], w_up, conv_w, conv_b, w_down)
    return x, ctx


def setup_inputs(seed: int = 0) -> dict:
    key = jax.random.key(seed)
    ks = jax.random.split(key, 20)
    f32 = jnp.float32
    L = DEPTH

    def nrm(k, shape, s):
        return jax.random.normal(k, shape, f32) * s

    gate_base = jnp.array([0.0, 3.0], f32)[None, None, :, None]
    return {
        'x': nrm(ks[0], (BATCH, SEQ, D_MODEL), 1.0),
        'c': nrm(ks[1], (BATCH, D_MODEL), 1.0),
        'ctx': nrm(ks[2], (BATCH, CTX_LEN, D_MODEL), 1.0),
        'c_ctx': nrm(ks[3], (D_MODEL,), 1.0),
        'w_mod': nrm(ks[4], (L, D_MODEL, 6 * D_MODEL), D_MODEL ** -0.5),
        'b_mod': nrm(ks[5], (L, 6 * D_MODEL), 0.01),
        'g_norm1': 1.0 + nrm(ks[6], (L, D_MODEL), 0.05),
        'g_norm2': 1.0 + nrm(ks[7], (L, D_MODEL), 0.05),
        'w_in': nrm(ks[8], (L, D_MODEL, PROJ_WIDTH), D_MODEL ** -0.5),
        'gla_w_lr': nrm(ks[9], (L, N_DIR, GLA_LR, GLA_HEADS * GLA_DK), GLA_LR ** -0.5),
        'gla_b_lr': nrm(ks[10], (L, N_DIR, GLA_HEADS * GLA_DK), 0.1),
        'mlstm_b_gate': gate_base + nrm(ks[11], (L, N_DIR, 2, MLSTM_HEADS), 0.1),
        'gla_g_norm': 1.0 + nrm(ks[12], (L, GLA_DV), 0.05),
        'mlstm_g_norm': 1.0 + nrm(ks[13], (L, MLSTM_DV), 0.05),
        'w_out': nrm(ks[14], (L, MIX_WIDTH, D_MODEL), MIX_WIDTH ** -0.5),
        'w_up': nrm(ks[15], (L, D_MODEL, 2 * D_FF), D_MODEL ** -0.5),
        'conv_w': nrm(ks[16], (L, CONV_K, CONV_K, D_FF), 1.0 / CONV_K),
        'conv_b': nrm(ks[17], (L, D_FF), 0.01),
        'w_down': nrm(ks[18], (L, D_FF, D_MODEL), D_FF ** -0.5),
        'g_final': 1.0 + nrm(ks[19], (D_MODEL,), 0.05),
    }


def reference(x, c, ctx, c_ctx, w_mod, b_mod, g_norm1, g_norm2, w_in, gla_w_lr, gla_b_lr, mlstm_b_gate,
              gla_g_norm, mlstm_g_norm, w_out, w_up, conv_w, conv_b, w_down, g_final):
    c_act = jax.nn.silu(c)
    cc_act = jax.nn.silu(c_ctx)
    for l in range(DEPTH):
        x, ctx = trunk_layer(x, ctx, c_act, cc_act, w_mod[l], b_mod[l], g_norm1[l], g_norm2[l], w_in[l],
                             gla_w_lr[l], gla_b_lr[l], mlstm_b_gate[l], gla_g_norm[l], mlstm_g_norm[l],
                             w_out[l], w_up[l], conv_w[l], conv_b[l], w_down[l],
                             update_ctx=(l < DEPTH - 1))
    return rmsnorm(x, g_final)
```

```cpp
#include <hip/hip_runtime.h>
#include <hip/hip_cooperative_groups.h>
#include <cstdio>
namespace cg = cooperative_groups;

#ifndef MULTI_LAUNCH
#define MULTI_LAUNCH 0
#endif


#ifndef REP_SCAN
#define REP_SCAN 1
#endif
#ifndef REP_GEMM
#define REP_GEMM 1
#endif
#ifndef REP_MISC
#define REP_MISC 1
#endif
#define LAS __attribute__((address_space(3)))
typedef unsigned short bf16_t;
typedef short bf16x8 __attribute__((ext_vector_type(8)));
typedef float f32x4 __attribute__((ext_vector_type(4)));
typedef unsigned u32x4 __attribute__((ext_vector_type(4)));
typedef unsigned u32x2 __attribute__((ext_vector_type(2)));

constexpr int DM = 2048, NB = 4, TL = 4096, TC = 256, NLAYER = 2;
constexpr int RL = NB * TL, RC = NB * TC, RT = RL + RC;
constexpr int PW = 6176, PWP = 6400, DFF = 5504, DFF2 = 11008;
constexpr int MODW = 6 * DM;
constexpr float EPS = 1e-6f;
constexpr int ZC_GQ = 0, ZC_GK = 512, ZC_GV = 1024, ZC_GG = 2048, ZC_MQ = 3072, ZC_MK = 3584, ZC_MV = 4096, ZC_MO = 5120, ZC_LR = 6144, ZC_MG = 6160;

constexpr size_t WS_UZ = 0;
constexpr size_t SZ_U = (size_t)RT * DFF2 * 2;
constexpr size_t WS_Z = WS_UZ;
constexpr size_t SZ_Z = (size_t)RT * PWP * 2;
constexpr size_t WS_O = WS_Z + SZ_Z;
constexpr size_t SZ_O1 = (size_t)RT * DM * 2;
static_assert(SZ_Z + 2 * SZ_O1 <= SZ_U, "overlay");
constexpr size_t WS_X = WS_UZ + SZ_U;
constexpr size_t WS_A = WS_X + (size_t)RT * DM * 4;
constexpr size_t WS_WIN = WS_A + (size_t)RT * DM * 2;
constexpr size_t WS_WOUT = WS_WIN + (size_t)PWP * DM * 2;
constexpr size_t WS_WUP = WS_WOUT + (size_t)DM * DM * 2;
constexpr size_t WS_WDN = WS_WUP + (size_t)DFF2 * DM * 2;
constexpr size_t WS_MOD = WS_WDN + (size_t)DM * DFF * 2;
constexpr size_t WS_BAR = WS_MOD + (size_t)NLAYER * 5 * MODW * 4;
constexpr size_t WS_EEND = WS_BAR + 16384;
constexpr size_t WS_PART = WS_EEND + (size_t)2 * (RT / 64) * 512 * 4;
constexpr size_t WS_MQK = WS_PART;
constexpr size_t SZ_MQK = (size_t)2 * RT * 512 * 2;
constexpr size_t WS_GATES = WS_PART + (SZ_MQK > (size_t)4 * RC * DM * 4 ? SZ_MQK : (size_t)4 * RC * DM * 4);
constexpr size_t WS_END = WS_GATES + (size_t)2 * 4 * 3 * RT * 4;

struct Params {
    const float *x, *c, *ctx, *c_ctx, *w_mod, *b_mod, *g_norm1, *g_norm2, *w_in, *gla_w_lr, *gla_b_lr, *mlstm_b_gate,
        *gla_g_norm, *mlstm_g_norm, *w_out, *w_up, *conv_w, *conv_b, *w_down, *g_final;
    float* out;
    unsigned char* ws;
    long long ph_lo, ph_hi;
};

__device__ __forceinline__ float bf2f(unsigned short h) { return __uint_as_float(((unsigned)h) << 16); }
__device__ __forceinline__ unsigned short f2bf(float f) { unsigned u = __float_as_uint(f); u += 0x7FFFu + ((u >> 16) & 1u); return (unsigned short)(u >> 16); }
typedef __bf16 bf16x2_t __attribute__((ext_vector_type(2)));
typedef float f32x2_t __attribute__((ext_vector_type(2)));
__device__ __forceinline__ unsigned cvt_pk_bf16(float lo, float hi) { const f32x2_t v = {lo, hi}; return __builtin_bit_cast(unsigned, __builtin_convertvector(v, bf16x2_t)); }
__device__ __forceinline__ float lo_bf(unsigned w) { return __uint_as_float(w << 16); }
__device__ __forceinline__ float hi_bf(unsigned w) { return __uint_as_float(w & 0xffff0000u); }
__device__ __forceinline__ float sigmoidf_(float x) { return __builtin_amdgcn_rcpf(1.0f + __expf(-x)); }
__device__ __forceinline__ float siluf_(float x) { return x * __builtin_amdgcn_rcpf(1.0f + __expf(-x)); }
__device__ __forceinline__ float logsigf_(float x) { return fminf(x, 0.f) - __logf(1.0f + __expf(-fabsf(x))); }
__device__ __forceinline__ int otid() { int t = threadIdx.x; asm volatile("" : "+v"(t)); return t; }
template <int CTRL, int RM> __device__ __forceinline__ float dpp_f(float v, float old) {
    return __int_as_float(__builtin_amdgcn_update_dpp(__float_as_int(old), __float_as_int(v), CTRL, RM, 0xF, false));
}
__device__ __forceinline__ float wave_incl_sum(float v) {
    v += dpp_f<0x111, 0xF>(v, 0.f); v += dpp_f<0x112, 0xF>(v, 0.f); v += dpp_f<0x114, 0xF>(v, 0.f); v += dpp_f<0x118, 0xF>(v, 0.f);
    v += dpp_f<0x142, 0xA>(v, 0.f); v += dpp_f<0x143, 0xC>(v, 0.f); return v;
}
__device__ __forceinline__ float wave_incl_max(float v) {
    const float ninf = __int_as_float(0xff800000);
    v = fmaxf(v, dpp_f<0x111, 0xF>(v, ninf)); v = fmaxf(v, dpp_f<0x112, 0xF>(v, ninf)); v = fmaxf(v, dpp_f<0x114, 0xF>(v, ninf)); v = fmaxf(v, dpp_f<0x118, 0xF>(v, ninf));
    v = fmaxf(v, dpp_f<0x142, 0xA>(v, ninf)); v = fmaxf(v, dpp_f<0x143, 0xC>(v, ninf)); return v;
}
__device__ __forceinline__ float rdlane63(float v) { return __int_as_float(__builtin_amdgcn_readlane(__float_as_int(v), 63)); }
__device__ __forceinline__ float wave_sum(float v) { return rdlane63(wave_incl_sum(v)); }
__device__ __forceinline__ float wave_max(float v) { return rdlane63(wave_incl_max(v)); }


#define XB_TMO      128
#define XB_XCNT(j)  (256  + 64 * (j))
#define XB_XSUB(j)  (1280 + 64 * (j))
#define XB_XGEN(j)  (2304 + 64 * (j))
#define XB_TOP      3328
#define XB_TOPGEN   3392
#define XCD_BAR_WORDS 3456
#define XB_SPIN_CAP (1u << 22)
__device__ __forceinline__ unsigned xb_ld(unsigned* p)              { return __hip_atomic_load(p, __ATOMIC_RELAXED, __HIP_MEMORY_SCOPE_AGENT); }
__device__ __forceinline__ unsigned xb_add(unsigned* p, unsigned v) { return __hip_atomic_fetch_add(p, v, __ATOMIC_RELAXED, __HIP_MEMORY_SCOPE_AGENT); }
__device__ __forceinline__ unsigned xb_xcc_id() { return (unsigned)__builtin_amdgcn_s_getreg((3 << 11) | 20) & 0xFu; }
#define XB_SPIN(cond, bar) do { unsigned _sp = 0; while (cond) { __builtin_amdgcn_s_sleep(1); \
    if ((++_sp & 255u) == 0u) { if (xb_ld(&(bar)[XB_TMO])) break; if (_sp > XB_SPIN_CAP) { atomicAdd(&(bar)[XB_TMO], 1u); break; } } } } while (0)
struct XcdBarrier { unsigned* bar; unsigned x; volatile LAS unsigned* st; };
__device__ __forceinline__ XcdBarrier xcd_barrier_post(unsigned* bar, volatile LAS unsigned* st) {
    XcdBarrier b; b.bar = bar; b.x = xb_xcc_id(); b.st = st;
    if (threadIdx.x == 0) (void)xb_add(&bar[XB_XCNT(b.x)], 1u);
    return b;
}
__device__ __forceinline__ void xcd_barrier_complete(unsigned* bar, unsigned x, unsigned& nloc, unsigned& nx) {
    const unsigned G = gridDim.x * gridDim.y * gridDim.z;
    unsigned sum, cnt, mine, sp = 0u;
    for (;;) {
        sum = 0u; cnt = 0u; mine = 0u;
#pragma unroll
        for (unsigned j = 0; j < 16; ++j) { const unsigned c = xb_ld(&bar[XB_XCNT(j)]); sum += c; cnt += (c > 0u) ? 1u : 0u; mine = (j == x) ? c : mine; }
        if (sum == G) break;
        __builtin_amdgcn_s_sleep(1);
        if ((++sp & 255u) == 0u) { if (xb_ld(&bar[XB_TMO])) break; if (sp > XB_SPIN_CAP) { atomicAdd(&bar[XB_TMO], 1u); break; } }
    }
    nloc = mine > 0u ? mine : 1u; nx = cnt > 0u ? cnt : 1u;
}
__device__ __forceinline__ void xcd_barrier(const XcdBarrier& b) {
    asm volatile("s_waitcnt vmcnt(0)" ::: "memory");
    __syncthreads();
    if (threadIdx.x == 0) {
        unsigned* bar = b.bar;
        __builtin_amdgcn_s_waitcnt(0);
        unsigned nloc = b.st[0], nx = b.st[1];
        if (nloc == 0u) { xcd_barrier_complete(bar, b.x, nloc, nx); b.st[0] = nloc; b.st[1] = nx; }
        const unsigned old = xb_add(&bar[XB_XSUB(b.x)], 1u);
        const unsigned gen = old / nloc;
        if (old + 1u == (gen + 1u) * nloc) {
            __builtin_amdgcn_fence(__ATOMIC_RELEASE, "agent");
            asm volatile("s_waitcnt vmcnt(0)" ::: "memory");
            const unsigned og = xb_add(&bar[XB_TOP], 1u);
            const unsigned tg = og / nx;
            if (og + 1u == (tg + 1u) * nx) xb_add(&bar[XB_TOPGEN], 1u);
            else XB_SPIN(xb_ld(&bar[XB_TOPGEN]) == tg, bar);
            __builtin_amdgcn_fence(__ATOMIC_ACQUIRE, "agent");
            xb_add(&bar[XB_XGEN(b.x)], 1u);
            asm volatile("s_waitcnt vmcnt(0)" ::: "memory");
        } else {
            XB_SPIN(xb_ld(&bar[XB_XGEN(b.x)]) == gen, bar);
            __builtin_amdgcn_fence(__ATOMIC_ACQUIRE, "agent");
            asm volatile("s_waitcnt vmcnt(0)" ::: "memory");
        }
    }
    __syncthreads();
}

namespace pg8 {
constexpr int BM = 256, BK = 64, HALF = 128, HTB = HALF * BK * 2, STAGE_BYTES = 8 * HTB, NXCD = 8, WGM = 4;
__host__ __device__ __forceinline__ int lds_byte(int r, int c) { const int st = (r >> 4) * 2 + (c >> 5), rr = r & 15, cc = c & 31, ob = rr * 64 + cc * 2; return st * 1024 + (ob ^ (((ob >> 9) & 1) << 5)); }
__host__ __device__ __forceinline__ void stage_rc(int b, int& R, int& C) { const int st = b / 1024, sb = b % 1024, swz = sb ^ (((sb >> 9) & 1) << 5); R = (st >> 1) * 16 + swz / 64; C = (st & 1) * 32 + (swz % 64) / 2; }
__host__ __device__ __forceinline__ int perm32(int rho) { const int n = rho >> 4, i = rho & 15; return 8 * (i >> 2) + 4 * n + (i & 3); }
struct Unit { int pm, pn, kt0, nt, piece; };
struct Gemm { const bf16_t* A; const bf16_t* Bt; int M, N, K, lda; };
struct StaticOrder {
    int nM, nN, nwg, G, c, ntK;
    __host__ __device__ void init(int M, int N, int G_, int c_, int K_ = 0) { nM = M / BM; nN = N / BM; nwg = nM * nN; G = G_; c = c_; ntK = K_ / BK; }
    __host__ __device__ bool next(int i, Unit& u) const {
        const long L = (long)i * G + c; if (L >= nwg) return false;
        int wgid = (int)L;
#ifndef NO_XCD_REMAP
        { const int q = nwg / NXCD, r = nwg % NXCD, xcd = wgid % NXCD, off = wgid / NXCD; wgid = (xcd < r ? xcd * (q + 1) : r * (q + 1) + (xcd - r) * q) + off; }
#endif
        const int nig = WGM * nN, gid = wgid / nig, fm = gid * WGM, gsz = (nM - fm) < WGM ? (nM - fm) : WGM;
        u.pm = fm + ((wgid % nig) % gsz); u.pn = (wgid % nig) / gsz; u.kt0 = 0; u.nt = ntK; u.piece = 0; return true;
    }
};
struct SplitTailOrder {
    StaticOrder lat; int ntK, nlat, npieces;
    __host__ __device__ void init(int N, int G_, int c_, int K_, bool with_ctx) { lat.init(RL, N, G_, c_, K_); ntK = K_ / BK; nlat = lat.nwg; npieces = with_ctx ? 32 * 4 : 0; }
    __host__ __device__ bool next(int i, Unit& u) const {
        const long L = (long)i * lat.G + lat.c;
        u.pm = 0; u.pn = 0; u.kt0 = 0; u.nt = ntK; u.piece = 0;
        if (L < nlat) { Unit t; t.pm = 0; t.pn = 0; t.kt0 = 0; t.nt = ntK; t.piece = 0; const bool ok = lat.next(i, t); u.pm = t.pm; u.pn = t.pn; return ok; }
        const int q = (int)(L - nlat); if (q >= npieces) return false;
        const int uu = q >> 2, piece = q & 3;
        u.pm = 64 + (uu >> 3); u.pn = uu & 7; u.piece = piece;
        const int nb = ntK / 2;
        const int base = nb / 4, rem = nb % 4;
        const int b0 = piece * base + (piece < rem ? piece : rem), nbp = base + (piece < rem ? 1 : 0);
        u.kt0 = 2 * b0; u.nt = 2 * nbp; return true;
    }
};

struct EpiBf16 {
    static constexpr bool PERM = true;
    bf16_t* O; int ldc;
    __device__ __forceinline__ void operator()(const f32x4 (&acc)[2][2][4][2], const Unit& u, int wr, int wc, int fr, int fq) const {
        const int row0 = u.pm * BM + wr * 64 + fr; const int col0 = u.pn * BM + wc * 32 + 8 * fq;
#pragma unroll
        for (int ai = 0; ai < 2; ++ai)
#pragma unroll
            for (int m = 0; m < 4; ++m) { bf16_t* rowp = O + (size_t)(row0 + ai * HALF + m * 16) * ldc + col0;
#pragma unroll
                for (int bj = 0; bj < 2; ++bj) { const f32x4 v0 = acc[ai][bj][m][0], v1 = acc[ai][bj][m][1];
                    u32x4 w; w.x = cvt_pk_bf16(v0[0], v0[1]); w.y = cvt_pk_bf16(v0[2], v0[3]); w.z = cvt_pk_bf16(v1[0], v1[1]); w.w = cvt_pk_bf16(v1[2], v1[3]);
                    *(u32x4*)(rowp + bj * HALF) = w; } }
    }
};
struct EpiRes {
    static constexpr bool PERM = false;
    const float* base_lat; const float* base_ctx; float* out; const float* mod; int gt_off; float scale; int ntK; float* part;
    __device__ __forceinline__ void operator()(const f32x4 (&acc)[2][2][4][2], const Unit& u, int wr, int wc, int fr, int fq) const {
        const int bidx = u.pm < 64 ? (u.pm >> 4) : 4;
        const bool split = u.nt < ntK;
        const float* gt = mod + (size_t)bidx * MODW + gt_off;
        const int row0 = u.pm * BM + wr * 64 + fr, col0 = u.pn * BM + wc * 32 + 4 * fq;
        const float* bbase = u.pm < 64 ? base_lat : (base_ctx - (size_t)RL * DM);
        f32x4 gv[2][2];
#pragma unroll
        for (int bj = 0; bj < 2; ++bj)
#pragma unroll
            for (int n = 0; n < 2; ++n) gv[bj][n] = *(const f32x4*)(gt + col0 + bj * HALF + n * 16) * scale;
        if (split) {
#pragma unroll
            for (int ai = 0; ai < 2; ++ai)
#pragma unroll
                for (int m = 0; m < 4; ++m) { const size_t off = (size_t)(row0 + ai * HALF + m * 16) * DM + col0;
#pragma unroll
                    for (int bj = 0; bj < 2; ++bj)
#pragma unroll
                        for (int n = 0; n < 2; ++n) *(f32x4*)(part + (size_t)u.piece * RC * DM + (off - (size_t)RL * DM) + bj * HALF + n * 16) = gv[bj][n] * acc[ai][bj][m][n]; }
        } else {
#pragma unroll
            for (int ai = 0; ai < 2; ++ai)
                {
                    f32x4 bs[4][2][2];
#pragma unroll
                    for (int mm = 0; mm < 4; ++mm) { const size_t off = (size_t)(row0 + ai * HALF + mm * 16) * DM + col0;
#pragma unroll
                        for (int bj = 0; bj < 2; ++bj)
#pragma unroll
                            for (int n = 0; n < 2; ++n) bs[mm][bj][n] = *(const f32x4*)(bbase + off + bj * HALF + n * 16); }
#pragma unroll
                    for (int mm = 0; mm < 4; ++mm) { const size_t off = (size_t)(row0 + ai * HALF + mm * 16) * DM + col0;
#pragma unroll
                        for (int bj = 0; bj < 2; ++bj)
#pragma unroll
                            for (int n = 0; n < 2; ++n) *(f32x4*)(out + off + bj * HALF + n * 16) = bs[mm][bj][n] + gv[bj][n] * acc[ai][bj][mm][n]; }
                    asm volatile("" ::: "memory"); }
        }
        __builtin_amdgcn_s_waitcnt(0x0F70);
    }
};

#ifndef PG8_SP2
#define PG8_SP2 true
#endif
#ifndef PG8_ALIGN
#define PG8_ALIGN true
#endif
template <class Epi, class Sched, bool SP2 = PG8_SP2, bool ALIGN_EPI = PG8_ALIGN>
__device__ __forceinline__ void gemm_phase(LAS unsigned char* lds, const Gemm g, const Sched& S, const Epi& E) {
    int tid = threadIdx.x; asm volatile("" : "+v"(tid));
    const int wid = __builtin_amdgcn_readfirstlane(tid >> 6), lane = tid & 63, wr = wid >> 2, wc = wid & 3, fr = lane & 15, fq = lane >> 4;
    const int K = g.K, lda = g.lda;
    unsigned voffA[2], voffB[2];
#pragma unroll
    for (int i = 0; i < 2; ++i) { int R, C; stage_rc(tid * 16 + i * 8192, R, C); const int Rb = Epi::PERM ? ((R & ~31) + perm32(R & 31)) : R;
        voffA[i] = (unsigned)(R * lda + C) * 2u; voffB[i] = (unsigned)(Rb * K + C) * 2u; }
    const size_t kstep = (size_t)(BK * 2);
    const size_t hstepA = (size_t)HALF * lda * 2, hstepB = (size_t)HALF * K * 2;
    const size_t tstepA = 2 * hstepA, tstepB = 2 * hstepB;
    const unsigned ldsw = (unsigned)wid * 1024u;
    const int aoff = lds_byte(wr * 64 + fr, fq * 8), boff = lds_byte(wc * 32 + fr, fq * 8);
#define PG8_SA(b, h) (((b) * 2 + (h)) * HTB)
#define PG8_SB(b, h) ((4 + (b) * 2 + (h)) * HTB)
#define PG8_STAGE(bufoff, gbase, voff) do { _Pragma("unroll") for (int _i = 0; _i < 2; ++_i) \
        __builtin_amdgcn_global_load_lds((const unsigned*)((const char*)(gbase) + (voff)[_i]), (LAS unsigned*)(lds + (bufoff) + ldsw + _i * 8192), 16, 0, 0); } while (0)
#define PG8_LDA(dst, b, h) do { _Pragma("unroll") for (int m = 0; m < 4; ++m) _Pragma("unroll") for (int k = 0; k < 2; ++k) dst[m][k] = *(const LAS bf16x8*)(lds + PG8_SA(b, h) + aoff + m * 2048 + k * 1024); } while (0)
#define PG8_LDB(dst, b, h) do { _Pragma("unroll") for (int n = 0; n < 2; ++n) _Pragma("unroll") for (int k = 0; k < 2; ++k) dst[n][k] = *(const LAS bf16x8*)(lds + PG8_SB(b, h) + boff + n * 2048 + k * 1024); } while (0)
#define PG8_MMA(ai, bj, At, Bt) do { __builtin_amdgcn_s_setprio(1); _Pragma("unroll") for (int m = 0; m < 4; ++m) _Pragma("unroll") for (int n = 0; n < 2; ++n) _Pragma("unroll") for (int k = 0; k < 2; ++k) \
        acc[ai][bj][m][n] = __builtin_amdgcn_mfma_f32_16x16x32_bf16(Bt[n][k], At[m][k], acc[ai][bj][m][n], 0, 0, 0); __builtin_amdgcn_s_setprio(0); } while (0)
#define PG8_WAIT_V(n) asm volatile("s_waitcnt vmcnt(" #n ")" ::: "memory")
#define PG8_WAIT_L(n) asm volatile("s_waitcnt lgkmcnt(" #n ")" ::: "memory")
#define PG8_BAR __builtin_amdgcn_s_barrier()
#define PG8_SCHED __builtin_amdgcn_sched_barrier(0)
    Unit cur, nxt; int ui = 0;
    if (!S.next(0, cur)) return;
    f32x4 acc[2][2][4][2];
#pragma unroll
    for (int a = 0; a < 2; ++a)
#pragma unroll
        for (int b = 0; b < 2; ++b)
#pragma unroll
            for (int m = 0; m < 4; ++m)
#pragma unroll
                for (int n = 0; n < 2; ++n) acc[a][b][m][n] = (f32x4){0.f, 0.f, 0.f, 0.f};
    bf16x8 At[4][2], B0[2][2], B1[2][2];
    const char* cA = (const char*)g.A + (size_t)cur.pm * tstepA + (size_t)cur.kt0 * kstep; const char* cB = (const char*)g.Bt + (size_t)cur.pn * tstepB + (size_t)cur.kt0 * kstep;
    if constexpr (SP2) {
        PG8_STAGE(PG8_SB(0, 0), cB, voffB); PG8_STAGE(PG8_SB(0, 1), cB + hstepB, voffB); PG8_STAGE(PG8_SA(0, 0), cA, voffA); PG8_STAGE(PG8_SA(0, 1), cA + hstepA, voffA);
        if (wr == 1) PG8_BAR;
        PG8_WAIT_V(2); PG8_BAR;
        PG8_STAGE(PG8_SB(1, 0), cB + kstep, voffB); PG8_STAGE(PG8_SA(1, 0), cA + kstep, voffA); PG8_STAGE(PG8_SB(1, 1), cB + hstepB + kstep, voffB);
        PG8_WAIT_V(6); PG8_BAR;
    } else {
    PG8_STAGE(PG8_SB(0, 0), cB, voffB); PG8_STAGE(PG8_SA(0, 0), cA, voffA); PG8_STAGE(PG8_SB(0, 1), cB + hstepB, voffB); PG8_STAGE(PG8_SA(0, 1), cA + hstepA, voffA);
    if (wr == 1) PG8_BAR;
    PG8_WAIT_V(4); PG8_BAR;
    PG8_STAGE(PG8_SB(1, 0), cB + kstep, voffB); PG8_STAGE(PG8_SA(1, 0), cA + kstep, voffA); PG8_STAGE(PG8_SB(1, 1), cB + hstepB + kstep, voffB);
    PG8_WAIT_V(6); PG8_BAR;
    }
    for (;;) {
        const bool has_next = S.next(ui + 1, nxt);
        const char* nA = has_next ? (const char*)g.A + (size_t)nxt.pm * tstepA + (size_t)nxt.kt0 * kstep : cA; const char* nB = has_next ? (const char*)g.Bt + (size_t)nxt.pn * tstepB + (size_t)nxt.kt0 * kstep : cB;
        const int nt = cur.nt;
        for (int t = 0; t < nt; t += 2) {
            const bool last = (t == nt - 2);
            const char* a1 = cA + (size_t)(t + 1) * kstep;
            const char* a2 = last ? nA : cA + (size_t)(t + 2) * kstep; const char* b2 = last ? nB : cB + (size_t)(t + 2) * kstep;
            const char* a3 = a2 + kstep; const char* b3 = b2 + kstep;
            if constexpr (SP2) {
            PG8_LDB(B0, 0, 0); PG8_LDB(B1, 0, 1); PG8_SCHED; PG8_LDA(At, 0, 0); PG8_STAGE(PG8_SA(1, 1), a1 + hstepA, voffA);
            PG8_WAIT_V(8); PG8_WAIT_L(0); PG8_BAR; PG8_MMA(0, 0, At, B0); PG8_MMA(0, 1, At, B1); PG8_BAR; PG8_SCHED;
            PG8_LDA(At, 0, 1); PG8_STAGE(PG8_SB(0, 0), b2, voffB); PG8_STAGE(PG8_SB(0, 1), b2 + hstepB, voffB); PG8_STAGE(PG8_SA(0, 0), a2, voffA);
            PG8_WAIT_V(8); PG8_WAIT_L(0); PG8_BAR; PG8_MMA(1, 0, At, B0); PG8_MMA(1, 1, At, B1); PG8_BAR; PG8_SCHED;
            PG8_LDB(B0, 1, 0); PG8_LDB(B1, 1, 1); PG8_SCHED; PG8_LDA(At, 1, 0); PG8_STAGE(PG8_SA(0, 1), a2 + hstepA, voffA);
            PG8_WAIT_V(8); PG8_WAIT_L(0); PG8_BAR; PG8_MMA(0, 0, At, B0); PG8_MMA(0, 1, At, B1); PG8_BAR; PG8_SCHED;
            PG8_LDA(At, 1, 1); PG8_STAGE(PG8_SB(1, 0), b3, voffB); PG8_STAGE(PG8_SB(1, 1), b3 + hstepB, voffB); PG8_STAGE(PG8_SA(1, 0), a3, voffA);
            PG8_WAIT_V(8); PG8_WAIT_L(0); PG8_BAR; PG8_MMA(1, 0, At, B0); PG8_MMA(1, 1, At, B1); PG8_BAR; PG8_SCHED;
            } else {
            PG8_LDB(B0, 0, 0); PG8_SCHED; PG8_LDA(At, 0, 0); PG8_STAGE(PG8_SA(1, 1), a1 + hstepA, voffA);
            PG8_WAIT_L(8); PG8_BAR; PG8_WAIT_L(0); PG8_MMA(0, 0, At, B0); PG8_BAR; PG8_SCHED;
            PG8_LDB(B1, 0, 1); PG8_STAGE(PG8_SB(0, 0), b2, voffB);
            PG8_BAR; PG8_WAIT_L(0); PG8_MMA(0, 1, At, B1); PG8_BAR;
            PG8_LDA(At, 0, 1); PG8_STAGE(PG8_SA(0, 0), a2, voffA);
            PG8_BAR; PG8_WAIT_L(0); PG8_MMA(1, 0, At, B0); PG8_BAR; PG8_SCHED;
            PG8_STAGE(PG8_SB(0, 1), b2 + hstepB, voffB);
            PG8_WAIT_V(6); PG8_BAR; PG8_MMA(1, 1, At, B1); PG8_BAR;
            PG8_LDB(B0, 1, 0); PG8_SCHED; PG8_LDA(At, 1, 0); PG8_STAGE(PG8_SA(0, 1), a2 + hstepA, voffA);
            PG8_WAIT_L(8); PG8_BAR; PG8_WAIT_L(0); PG8_MMA(0, 0, At, B0); PG8_BAR; PG8_SCHED;
            PG8_LDB(B1, 1, 1); PG8_STAGE(PG8_SB(1, 0), b3, voffB);
            PG8_BAR; PG8_WAIT_L(0); PG8_MMA(0, 1, At, B1); PG8_BAR;
            PG8_LDA(At, 1, 1); PG8_STAGE(PG8_SA(1, 0), a3, voffA);
            PG8_BAR; PG8_WAIT_L(0); PG8_MMA(1, 0, At, B0); PG8_BAR; PG8_SCHED;
            PG8_STAGE(PG8_SB(1, 1), b3 + hstepB, voffB);
            PG8_WAIT_V(6); PG8_BAR; PG8_MMA(1, 1, At, B1); PG8_BAR;
            }
        }
        if constexpr (ALIGN_EPI) { if (wr == 0) PG8_BAR; }
        E(acc, cur, wr, wc, fr, fq);
        if (!has_next) break;
#pragma unroll
        for (int a = 0; a < 2; ++a)
#pragma unroll
            for (int b = 0; b < 2; ++b)
#pragma unroll
                for (int m = 0; m < 4; ++m)
#pragma unroll
                    for (int n = 0; n < 2; ++n) acc[a][b][m][n] = (f32x4){0.f, 0.f, 0.f, 0.f};
        cur = nxt; cA = nA; cB = nB; ++ui;
        if constexpr (ALIGN_EPI) { if (wr == 1) PG8_BAR; }
    }
    PG8_WAIT_V(0);
    if constexpr (!ALIGN_EPI) { if (wr == 0) PG8_BAR; }
    PG8_BAR;
#undef PG8_SA
#undef PG8_SB
#undef PG8_STAGE
#undef PG8_LDA
#undef PG8_LDB
#undef PG8_MMA
#undef PG8_WAIT_V
#undef PG8_WAIT_L
#undef PG8_BAR
#undef PG8_SCHED
}
}

constexpr int LDS_BYTES = pg8::STAGE_BYTES + 16;

__device__ __forceinline__ void phase_mod(const Params& p, LAS unsigned char* lds) {
    LAS float* act = (LAS float*)lds;
    LAS float* part = (LAS float*)(lds + 40960);
    const int tid = otid();
    for (int i = tid; i < 5 * DM; i += 512) { const int r = i / DM, k = i % DM; const float v = r < 4 ? p.c[r * DM + k] : p.c_ctx[k]; act[i] = siluf_(v); }
    __syncthreads();
    float* modout = (float*)(p.ws + WS_MOD);
    for (int unit = blockIdx.x; unit < 2 * 128; unit += gridDim.x) {
        const int l = unit >> 7, n0 = (unit & 127) * 96;
        const int c4 = tid % 24, kg = tid / 24;
        f32x4 a0 = {0, 0, 0, 0}, a1 = a0, a2 = a0, a3 = a0, a4 = a0;
        if (kg < 21) {
            const float* wp = p.w_mod + (size_t)l * DM * MODW + n0 + c4 * 4;
            for (int k0 = kg; k0 < DM; k0 += 21 * 7) {
                f32x4 w[7]; int kk[7]; float ok[7];
#pragma unroll
                for (int u = 0; u < 7; ++u) { const int k = k0 + 21 * u; const bool in = k < DM; kk[u] = in ? k : kg; ok[u] = in ? 1.0f : 0.0f; w[u] = *(const f32x4*)(wp + (size_t)kk[u] * MODW); }
#pragma unroll
                for (int u = 0; u < 7; ++u) { const f32x4 wu = w[u] * ok[u]; const int k = kk[u];
                    a0 += act[k] * wu; a1 += act[DM + k] * wu; a2 += act[2 * DM + k] * wu; a3 += act[3 * DM + k] * wu; a4 += act[4 * DM + k] * wu; }
            }
            LAS float* pp = part + kg * 480 + c4 * 4;
            *(LAS f32x4*)(pp) = a0; *(LAS f32x4*)(pp + 96) = a1; *(LAS f32x4*)(pp + 192) = a2; *(LAS f32x4*)(pp + 288) = a3; *(LAS f32x4*)(pp + 384) = a4;
        }
        __syncthreads();
        if (tid < 480) {
            const int r = tid / 96, cc = tid % 96; float s = p.b_mod[l * MODW + n0 + cc];
            for (int g = 0; g < 21; ++g) s += part[g * 480 + tid];
            modout[((size_t)l * 5 + r) * MODW + n0 + cc] = s;
        }
        __syncthreads();
    }
}

struct WcTile { const float* src; bf16_t* dst; int K, N, k0, n0; bool is_win; };
constexpr int WC_T_IN = 32 * 25, WC_T_OUT = 32 * 8, WC_T_UP = 32 * 43, WC_T_DN = 86 * 8;
constexpr int WC_TOT = WC_T_IN + WC_T_OUT + WC_T_UP + WC_T_DN, WC_NODN = WC_T_IN + WC_T_OUT + WC_T_UP, WC_TAIL0 = 600;
__device__ __forceinline__ WcTile wc_decode(const Params& p, int l, int t) {
    WcTile w;
    if (t < WC_T_IN) { const int kt = t % 32, nt = t / 32; w.src = p.w_in + (size_t)l * DM * PW; w.dst = (bf16_t*)(p.ws + WS_WIN); w.K = DM; w.N = PW; w.k0 = kt * 64; w.n0 = nt * 256; w.is_win = true; }
    else if (t < WC_T_IN + WC_T_OUT) { const int u = t - WC_T_IN; const int kt = u % 32, nt = u / 32; w.src = p.w_out + (size_t)l * DM * DM; w.dst = (bf16_t*)(p.ws + WS_WOUT); w.K = DM; w.N = DM; w.k0 = kt * 64; w.n0 = nt * 256; w.is_win = false; }
    else if (t < WC_NODN) { const int u = t - WC_T_IN - WC_T_OUT; const int kt = u % 32, nt = u / 32; w.src = p.w_up + (size_t)l * DM * DFF2; w.dst = (bf16_t*)(p.ws + WS_WUP); w.K = DM; w.N = DFF2; w.k0 = kt * 64; w.n0 = nt * 256; w.is_win = false; }
    else { const int u = t - WC_NODN; const int kt = u % 86, nt = u / 86; w.src = p.w_down + (size_t)l * DFF * DM; w.dst = (bf16_t*)(p.ws + WS_WDN); w.K = DFF; w.N = DM; w.k0 = kt * 64; w.n0 = nt * 256; w.is_win = false; }
    return w;
}
__device__ __forceinline__ void wc_load(const WcTile& w, int tid, f32x4 (&v)[4][2]) {
    const int r = tid >> 4, c4 = tid & 15;
#pragma unroll
    for (int j = 0; j < 4; ++j) {
        const int n = w.n0 + j * 64 + c4 * 4; int on = n;
        if (w.is_win) { if (n >= 6176) on = -1; else if (n >= 6160) on = n; else if (n >= 6144) on = 3072 + (n - 6144); else if (n >= 3072) on = n + 16; }
#pragma unroll
        for (int rr = 0; rr < 2; ++rr) {
            v[j][rr] = (f32x4){0.f, 0.f, 0.f, 0.f};
            if (on >= 0) v[j][rr] = *(const f32x4*)(w.src + (size_t)(w.k0 + r + rr * 32) * w.N + on);
        }
    }
}
__device__ __forceinline__ void phase_wconv(const Params& p, int l, LAS unsigned char* lds, int t_begin = 0, int t_end = WC_TOT, int first_block = 0) {
    LAS float* tile = (LAS float*)lds;
    if ((int)blockIdx.x < first_block) return;
    const int tid = otid();
    const int stride = (int)gridDim.x - first_block;
    int t = t_begin + (int)blockIdx.x - first_block;
    if (t >= t_end) return;
    f32x4 v[4][2];
    { const WcTile first = wc_decode(p, l, t); wc_load(first, tid, v); }
    for (;;) {
        {
            const int r = tid >> 4, c4 = tid & 15;
#pragma unroll
            for (int j = 0; j < 4; ++j)
#pragma unroll
                for (int rr = 0; rr < 2; ++rr) {
                    const int k = r + rr * 32; LAS float* tp = tile + (j * 64 + c4 * 4) * 65 + k;
                    tp[0] = v[j][rr][0]; tp[65] = v[j][rr][1]; tp[130] = v[j][rr][2]; tp[195] = v[j][rr][3];
                }
        }
        __syncthreads();
        const int tn = t + stride; const bool more = tn < t_end;
        if (more) { const WcTile nxt = wc_decode(p, l, tn); wc_load(nxt, tid, v); }
        const WcTile cur = wc_decode(p, l, t);
#pragma unroll
        for (int q = 0; q < 4; ++q) {
            const int n = q * 64 + (tid >> 3), seg = tid & 7;
            const LAS float* tp = tile + n * 65 + seg * 8;
            u32x4 w; w.x = cvt_pk_bf16(tp[0], tp[1]); w.y = cvt_pk_bf16(tp[2], tp[3]); w.z = cvt_pk_bf16(tp[4], tp[5]); w.w = cvt_pk_bf16(tp[6], tp[7]);
            *(u32x4*)(cur.dst + (size_t)(cur.n0 + n) * cur.K + cur.k0 + seg * 8) = w;
        }
        __syncthreads();
        if (!more) break;
        t = tn;
    }
}

__device__ __forceinline__ void phase_norm(const float* src_lat, const float* src_ctx, const float* g, const float* mod, int sh_off, int sc_off, int nrows, bf16_t* dst, const float* part = nullptr, float* ctx_wb = nullptr) {
    const int tid_ = otid(); const int lane = tid_ & 63, wv = tid_ >> 6;
    for (int row = blockIdx.x * 8 + wv; row < nrows; row += gridDim.x * 8) {
        const float* xr = row < RL ? src_lat + (size_t)row * DM : src_ctx + (size_t)(row - RL) * DM;
        const int bidx = row < RL ? (row >> 12) : 4;
        const float* mr = mod + (size_t)bidx * MODW;
        f32x4 v[8]; float ss = 0.f;
#pragma unroll
        for (int it = 0; it < 8; ++it) { v[it] = *(const f32x4*)(xr + (it * 64 + lane) * 4); }
        if (part != nullptr && row >= RL) {
            const float* pr = part + (size_t)(row - RL) * DM; float* wb = ctx_wb + (size_t)(row - RL) * DM;
#pragma unroll
            for (int it = 0; it < 8; ++it) { const int col = (it * 64 + lane) * 4;
                v[it] += (*(const f32x4*)(pr + col) + *(const f32x4*)(pr + (size_t)RC * DM + col)) + (*(const f32x4*)(pr + (size_t)2 * RC * DM + col) + *(const f32x4*)(pr + (size_t)3 * RC * DM + col));
                *(f32x4*)(wb + col) = v[it]; }
        }
#pragma unroll
        for (int it = 0; it < 8; ++it) ss += v[it][0] * v[it][0] + v[it][1] * v[it][1] + v[it][2] * v[it][2] + v[it][3] * v[it][3];
        f32x4 pg[8], psc[8], psh[8];
#pragma unroll
        for (int it = 0; it < 8; ++it) { const int col = (it * 64 + lane) * 4; pg[it] = *(const f32x4*)(g + col); psc[it] = *(const f32x4*)(mr + sc_off + col); psh[it] = *(const f32x4*)(mr + sh_off + col); }
        ss = wave_sum(ss);
        const float rstd = rsqrtf(ss * (1.0f / DM) + EPS);
#pragma unroll
        for (int it = 0; it < 8; ++it) {
            const int col = (it * 64 + lane) * 4;
            const f32x4 h = v[it] * rstd * pg[it] * (1.0f + psc[it]) + psh[it];
            u32x2 w; w.x = cvt_pk_bf16(h[0], h[1]); w.y = cvt_pk_bf16(h[2], h[3]);
            *(u32x2*)(dst + (size_t)row * DM + col) = w;
        }
    }
}
__device__ __forceinline__ void phase_final_norm(const float* src, const float* g, float* out) {
    const int tid_ = otid(); const int lane = tid_ & 63, wv = tid_ >> 6;
    for (int row = blockIdx.x * 8 + wv; row < RL; row += gridDim.x * 8) {
        const float* xr = src + (size_t)row * DM;
        f32x4 v[8]; float ss = 0.f;
#pragma unroll
        for (int it = 0; it < 8; ++it) { v[it] = *(const f32x4*)(xr + (it * 64 + lane) * 4); ss += v[it][0] * v[it][0] + v[it][1] * v[it][1] + v[it][2] * v[it][2] + v[it][3] * v[it][3]; }
        f32x4 pg[8];
#pragma unroll
        for (int it = 0; it < 8; ++it) pg[it] = *(const f32x4*)(g + (it * 64 + lane) * 4);
        ss = wave_sum(ss);
        const float rstd = rsqrtf(ss * (1.0f / DM) + EPS);
#pragma unroll
        for (int it = 0; it < 8; ++it) { const int col = (it * 64 + lane) * 4; *(f32x4*)(out + (size_t)row * DM + col) = v[it] * rstd * pg[it]; }
    }
}

__device__ __forceinline__ void phase_merge(const Params& p, int l, int nrows) {
    const bf16_t* Z = (const bf16_t*)(p.ws + WS_Z);
    const bf16_t* O0 = (const bf16_t*)(p.ws + WS_O);
    const bf16_t* O1 = (const bf16_t*)(p.ws + WS_O + SZ_O1);
    bf16_t* Y = (bf16_t*)(p.ws + WS_A);
    const int tid_ = otid(); const int lane = tid_ & 63, wv = tid_ >> 6;
    const f32x4 gg = *(const f32x4*)(p.gla_g_norm + l * 256 + lane * 4), gm = *(const f32x4*)(p.mlstm_g_norm + l * 256 + lane * 4);
    for (int row = blockIdx.x * 8 + wv; row < nrows; row += gridDim.x * 8) {
        u32x2 oa[8], ob[8], og[8];
#pragma unroll
        for (int hd = 0; hd < 8; ++hd) {
            const int col = hd * 256 + lane * 4;
            const int gcol = hd < 4 ? (ZC_GG + hd * 256 + lane * 4) : (ZC_MO + (hd - 4) * 256 + lane * 4);
            oa[hd] = *(const u32x2*)(O0 + (size_t)row * DM + col); ob[hd] = *(const u32x2*)(O1 + (size_t)row * DM + col); og[hd] = *(const u32x2*)(Z + (size_t)row * PWP + gcol);
        }
#pragma unroll
        for (int hd = 0; hd < 8; ++hd) {
            const int col = hd * 256 + lane * 4;
            const u32x2 a = oa[hd], b = ob[hd], gz = og[hd];
            f32x4 v; v[0] = lo_bf(a.x) + lo_bf(b.x); v[1] = hi_bf(a.x) + hi_bf(b.x); v[2] = lo_bf(a.y) + lo_bf(b.y); v[3] = hi_bf(a.y) + hi_bf(b.y);
            float ss = v[0] * v[0] + v[1] * v[1] + v[2] * v[2] + v[3] * v[3];
            ss = wave_sum(ss);
            const float rstd = rsqrtf(ss * (1.0f / 256.0f) + EPS);
            f32x4 gt; gt[0] = lo_bf(gz.x); gt[1] = hi_bf(gz.x); gt[2] = lo_bf(gz.y); gt[3] = hi_bf(gz.y);
            f32x4 y;
            if (hd < 4) { for (int e = 0; e < 4; ++e) y[e] = v[e] * rstd * gg[e] * siluf_(gt[e]); }
            else { for (int e = 0; e < 4; ++e) y[e] = sigmoidf_(gt[e]) * (v[e] * rstd * gm[e]); }
            u32x2 w; w.x = cvt_pk_bf16(y[0], y[1]); w.y = cvt_pk_bf16(y[2], y[3]);
            *(u32x2*)(Y + (size_t)row * DM + col) = w;
        }
    }
}

__device__ __forceinline__ void phase_conv(const Params& p, int l, bool with_ctx, bool dry = false) {
    bf16_t* U = (bf16_t*)(p.ws + WS_UZ);
    const float* cw = p.conv_w + (size_t)l * 9 * DFF;
    const float* cb = p.conv_b + (size_t)l * DFF;
    const int tid = otid();
    constexpr int NFG = DFF / 4;
    const int n_lat = NB * 64 * 8 * NFG, n_ctx = with_ctx ? NB * 32 * NFG : 0;
    for (int item = blockIdx.x * 512 + tid; item < n_lat + n_ctx; item += gridDim.x * 512) {
        int fg, rowbase, ncols, c0, nrowsg, r;
        if (item < n_lat) { fg = item % NFG; const int rest = item / NFG; const int seg = rest & 7; r = (rest >> 3) & 63; const int b = rest >> 9; rowbase = b * TL; ncols = 64; nrowsg = 64; c0 = seg * 8; }
        else { const int it2 = item - n_lat; fg = it2 % NFG; const int rest = it2 / NFG; const int seg = rest & 31, b = rest >> 5; rowbase = RL + b * TC; ncols = 256; nrowsg = 1; r = 0; c0 = seg * 8; }
        const int f0 = fg * 4;
        u32x2 G[3][10];
        float rowok[3];
#pragma unroll
        for (int dy = 0; dy < 3; ++dy) {
            const int rr = r + dy - 1; const bool rok = rr >= 0 && rr < nrowsg; rowok[dy] = rok ? 1.0f : 0.0f;
            const int rrc = rr < 0 ? 0 : (rr >= nrowsg ? nrowsg - 1 : rr);
#pragma unroll
            for (int j = 0; j < 10; ++j) {
                const int cc = c0 + j - 1; const int ccc = cc < 0 ? 0 : (cc >= ncols ? ncols - 1 : cc);
                G[dy][j] = *(const u32x2*)(U + (size_t)(rowbase + rrc * ncols + ccc) * DFF2 + f0);
            }
        }
        const bool lok = c0 > 0, rok9 = c0 + 8 < ncols;
#pragma unroll
        for (int dy = 0; dy < 3; ++dy) { if (!lok) G[dy][0] = (u32x2){0u, 0u}; if (!rok9) G[dy][9] = (u32x2){0u, 0u}; }
        u32x2 V[8];
        bf16_t* vp = U + (size_t)(rowbase + r * ncols + c0) * DFF2 + DFF + f0;
#pragma unroll
        for (int t = 0; t < 8; ++t) V[t] = *(const u32x2*)(vp + (size_t)t * DFF2);
        typedef float f32x2 __attribute__((ext_vector_type(2)));
        f32x2 W01[3][3], W23[3][3];
#pragma unroll
        for (int dy = 0; dy < 3; ++dy)
#pragma unroll
            for (int dx = 0; dx < 3; ++dx) { const f32x4 w = *(const f32x4*)(cw + (size_t)(dy * 3 + dx) * DFF + f0) * rowok[dy]; W01[dy][dx] = (f32x2){w[0], w[1]}; W23[dy][dx] = (f32x2){w[2], w[3]}; }
        const f32x4 bias = *(const f32x4*)(cb + f0);
        f32x2 P01[3][10], P23[3][10];
#pragma unroll
        for (int dy = 0; dy < 3; ++dy)
#pragma unroll
            for (int j = 0; j < 10; ++j) { const u32x2 g = G[dy][j];
                P01[dy][j] = (f32x2){lo_bf(g.x), hi_bf(g.x)}; P23[dy][j] = (f32x2){lo_bf(g.y), hi_bf(g.y)}; }
#pragma unroll
        for (int t = 0; t < 8; ++t) {
            f32x2 a01 = (f32x2){bias[0], bias[1]}, a23 = (f32x2){bias[2], bias[3]};
#pragma unroll
            for (int dy = 0; dy < 3; ++dy)
#pragma unroll
                for (int dx = 0; dx < 3; ++dx) { a01 = P01[dy][t + dx] * W01[dy][dx] + a01; a23 = P23[dy][t + dx] * W23[dy][dx] + a23; }
            u32x2 o;
            o.x = cvt_pk_bf16(siluf_(a01[0]) * lo_bf(V[t].x), siluf_(a01[1]) * hi_bf(V[t].x));
            o.y = cvt_pk_bf16(siluf_(a23[0]) * lo_bf(V[t].y), siluf_(a23[1]) * hi_bf(V[t].y));
            if (!dry || o.x == 0x7fc17fc1u) *(u32x2*)(vp + (size_t)t * DFF2) = o;
        }
    }
}

constexpr int NCHUNK = RT / 64;
__device__ __forceinline__ void phase_decay(const Params& p, int l, LAS unsigned char* lds) {
    LAS float* W = (LAS float*)lds;
    LAS float* Bv = (LAS float*)(lds + 65536);
    const int tid = otid(), lane = tid & 63, wv = tid >> 6;
    __syncthreads();
    {
        f32x4 wv4[8];
        const f32x4* wsrc = (const f32x4*)(p.gla_w_lr + (size_t)l * 2 * 16 * 512);
#pragma unroll
        for (int q = 0; q < 8; ++q) wv4[q] = wsrc[q * 512 + tid];
        float bvv[2];
#pragma unroll
        for (int q = 0; q < 2; ++q) bvv[q] = p.gla_b_lr[(size_t)l * 2 * 512 + q * 512 + tid];
#pragma unroll
        for (int q = 0; q < 8; ++q) ((LAS f32x4*)W)[q * 512 + tid] = wv4[q];
#pragma unroll
        for (int q = 0; q < 2; ++q) Bv[q * 512 + tid] = bvv[q];
    }
    __syncthreads();
    const bf16_t* Z = (const bf16_t*)(p.ws + WS_Z);
    bf16_t* QAg = (bf16_t*)(p.ws + WS_A);
    bf16_t* KAg = QAg + (size_t)2 * RT * 512;
    float* EEND = (float*)(p.ws + WS_EEND);
    const float qk_scale = 0.08838834764831845f;
    bf16_t* MQg = (bf16_t*)(p.ws + WS_MQK);
    bf16_t* MKg = MQg + (size_t)RT * 512;
    float* GATES = (float*)(p.ws + WS_GATES);
    u32x4 pf[6]; bool pf_valid = false;
#pragma unroll
    for (int q = 0; q < 6; ++q) pf[q] = (u32x4){0u, 0u, 0u, 0u};
    for (int item = blockIdx.x * 8 + wv; item < NCHUNK * 2 * 32 + NCHUNK * 32; item += gridDim.x * 8) {
        if (item >= NCHUNK * 2 * 32) {
            const int it2 = item - NCHUNK * 2 * 32, cg = it2 & 31, chunk = it2 >> 5;
            const int row = chunk * 64 + lane;
            const bf16_t* zr = Z + (size_t)row * PWP;
            const u32x4 q0 = *(const u32x4*)(zr + ZC_MQ + cg * 16), q1 = *(const u32x4*)(zr + ZC_MQ + cg * 16 + 8);
            const u32x4 k0 = *(const u32x4*)(zr + ZC_MK + cg * 16), k1 = *(const u32x4*)(zr + ZC_MK + cg * 16 + 8);
            const unsigned kw[8] = {k0.x, k0.y, k0.z, k0.w, k1.x, k1.y, k1.z, k1.w};
            unsigned ks[8];
#pragma unroll
            for (int e = 0; e < 8; ++e) ks[e] = cvt_pk_bf16(lo_bf(kw[e]) * qk_scale, hi_bf(kw[e]) * qk_scale);
            u32x4* qd = (u32x4*)(MQg + ((size_t)chunk * 32 + cg) * 1024 + lane * 16);
            u32x4* kd = (u32x4*)(MKg + ((size_t)chunk * 32 + cg) * 1024 + lane * 16);
            qd[0] = q0; qd[1] = q1;
            kd[0] = (u32x4){ks[0], ks[1], ks[2], ks[3]}; kd[1] = (u32x4){ks[4], ks[5], ks[6], ks[7]};
            if ((cg & 7) == 0) {
                const int h = cg >> 3;
#pragma unroll
                for (int dir = 0; dir < 2; ++dir) {
                    const float bi = p.mlstm_b_gate[((l * 2 + dir) * 2 + 0) * 4 + h], bf = p.mlstm_b_gate[((l * 2 + dir) * 2 + 1) * 4 + h];
                    const int rowd = chunk * 64 + (dir ? 63 - lane : lane);
                    const bf16_t* zd = Z + (size_t)rowd * PWP;
                    const float logi = bf2f(zd[ZC_MG + dir * 8 + h]) + bi;
                    const float logf = logsigf_(bf2f(zd[ZC_MG + dir * 8 + 4 + h]) + bf);
                    const float fcum = wave_incl_sum(logf), av = logi - fcum, aj = wave_incl_max(av);
                    GATES[(size_t)((dir * 4 + h) * 3 + 0) * RT + rowd] = fcum;
                    GATES[(size_t)((dir * 4 + h) * 3 + 1) * RT + rowd] = av;
                    GATES[(size_t)((dir * 4 + h) * 3 + 2) * RT + rowd] = aj;
                }
            }
            continue;
        }
        const int cg = item & 31, dir = (item >> 5) & 1, chunk = item >> 6;
        if (!pf_valid) { const int row = chunk * 64 + (dir ? 63 - lane : lane); const bf16_t* zr = Z + (size_t)row * PWP;
            pf[0] = *(const u32x4*)(zr + ZC_LR); pf[1] = *(const u32x4*)(zr + ZC_LR + 8); pf[2] = *(const u32x4*)(zr + ZC_GQ + cg * 16); pf[3] = *(const u32x4*)(zr + ZC_GQ + cg * 16 + 8);
            pf[4] = *(const u32x4*)(zr + ZC_GK + cg * 16); pf[5] = *(const u32x4*)(zr + ZC_GK + cg * 16 + 8); }
        const u32x4 g0 = pf[0], g1 = pf[1], q0 = pf[2], q1 = pf[3], k0 = pf[4], k1 = pf[5];
        {
            const int nitem = item + (int)gridDim.x * 8;
            pf_valid = nitem < NCHUNK * 2 * 32;
            if (pf_valid) { const int ncg = nitem & 31, ndir = (nitem >> 5) & 1, nchunk = nitem >> 6; const int nrow = nchunk * 64 + (ndir ? 63 - lane : lane); const bf16_t* zn = Z + (size_t)nrow * PWP;
                pf[0] = *(const u32x4*)(zn + ZC_LR); pf[1] = *(const u32x4*)(zn + ZC_LR + 8); pf[2] = *(const u32x4*)(zn + ZC_GQ + ncg * 16); pf[3] = *(const u32x4*)(zn + ZC_GQ + ncg * 16 + 8);
                pf[4] = *(const u32x4*)(zn + ZC_GK + ncg * 16); pf[5] = *(const u32x4*)(zn + ZC_GK + ncg * 16 + 8); }
        }
        const unsigned gw[8] = {g0.x, g0.y, g0.z, g0.w, g1.x, g1.y, g1.z, g1.w};
        const unsigned qw[8] = {q0.x, q0.y, q0.z, q0.w, q1.x, q1.y, q1.z, q1.w};
        const unsigned kw[8] = {k0.x, k0.y, k0.z, k0.w, k1.x, k1.y, k1.z, k1.w};
        float gl[16];
#pragma unroll
        for (int e = 0; e < 8; ++e) { gl[2 * e] = lo_bf(gw[e]); gl[2 * e + 1] = hi_bf(gw[e]); }
        unsigned qaw[8], kaw[8]; float eesel = 0.f;
#pragma unroll
        for (int c4 = 0; c4 < 4; ++c4) {
            const int ch0 = cg * 16 + c4 * 4;
            f32x4 dec = *(const LAS f32x4*)(Bv + dir * 512 + ch0);
#pragma unroll
            for (int r = 0; r < 16; ++r) dec += gl[r] * *(const LAS f32x4*)(W + (dir * 16 + r) * 512 + ch0);
            float qa[4], ka[4], la4[4];
#pragma unroll
            for (int e = 0; e < 4; ++e) la4[e] = logsigf_(dec[e]) * (1.0f / 16.0f);
#pragma unroll
            for (int e = 0; e < 4; ++e) la4[e] += dpp_f<0x111, 0xF>(la4[e], 0.f);
#pragma unroll
            for (int e = 0; e < 4; ++e) la4[e] += dpp_f<0x112, 0xF>(la4[e], 0.f);
#pragma unroll
            for (int e = 0; e < 4; ++e) la4[e] += dpp_f<0x114, 0xF>(la4[e], 0.f);
#pragma unroll
            for (int e = 0; e < 4; ++e) la4[e] += dpp_f<0x118, 0xF>(la4[e], 0.f);
#pragma unroll
            for (int e = 0; e < 4; ++e) la4[e] += dpp_f<0x142, 0xA>(la4[e], 0.f);
#pragma unroll
            for (int e = 0; e < 4; ++e) la4[e] += dpp_f<0x143, 0xC>(la4[e], 0.f);
#pragma unroll
            for (int e = 0; e < 4; ++e) {
                const int cc = c4 * 4 + e;
                const float la = la4[e];
                const float ev = __expf(la), eend = rdlane63(ev), rc = __builtin_amdgcn_rcpf(ev);
                const float qv = (cc & 1) ? hi_bf(qw[cc >> 1]) : lo_bf(qw[cc >> 1]);
                const float kv = (cc & 1) ? hi_bf(kw[cc >> 1]) : lo_bf(kw[cc >> 1]);
                qa[e] = qv * ev * qk_scale; ka[e] = kv * rc;
                eesel = (lane == cc) ? eend : eesel;
            }
            qaw[c4 * 2] = cvt_pk_bf16(qa[0], qa[1]); qaw[c4 * 2 + 1] = cvt_pk_bf16(qa[2], qa[3]);
            kaw[c4 * 2] = cvt_pk_bf16(ka[0], ka[1]); kaw[c4 * 2 + 1] = cvt_pk_bf16(ka[2], ka[3]);
        }
        u32x4* qd = (u32x4*)(QAg + (((size_t)dir * NCHUNK + chunk) * 32 + cg) * 1024 + lane * 16);
        u32x4* kd = (u32x4*)(KAg + (((size_t)dir * NCHUNK + chunk) * 32 + cg) * 1024 + lane * 16);
        qd[0] = (u32x4){qaw[0], qaw[1], qaw[2], qaw[3]}; qd[1] = (u32x4){qaw[4], qaw[5], qaw[6], qaw[7]};
        kd[0] = (u32x4){kaw[0], kaw[1], kaw[2], kaw[3]}; kd[1] = (u32x4){kaw[4], kaw[5], kaw[6], kaw[7]};
        if (lane < 16) EEND[((size_t)dir * NCHUNK + chunk) * 512 + cg * 16 + lane] = eesel;
    }
}

constexpr int SC_QA = 0, SC_KA = 17408, SC_KE = 34816, SC_VT = 53248  , SC_PP = 71680  , SC_ST = 90112, SC_AV = 108064, SC_MJ = 108320, SC_INTER = 108576, SC_MQ = 108832, SC_END = 109088;
constexpr int SC_VTB = 9216, SC_PPB = 9216;
constexpr int LD_QK = 136, LD_T = 72;
static_assert(SC_END <= LDS_BYTES, "scan lds");

__device__ __forceinline__ bf16x8 lds_frag(const LAS unsigned char* base, int row, int ld_elems, int kk, int fq) {
    return *(const LAS bf16x8*)(base + (size_t)(row * ld_elems + fq * 8 + kk * 32) * 2);
}
struct ScanIn { u32x4 q0, q1, k0, k1, vv; f32x4 ee; float gi, gf, ga; };

__device__ __forceinline__ void phase_scan(const Params& p, int l, LAS unsigned char* lds) {
    const bf16_t* Z = (const bf16_t*)(p.ws + WS_Z);
    const bf16_t* QAg = (const bf16_t*)(p.ws + WS_A);
    const bf16_t* KAg = QAg + (size_t)2 * RT * 512;
    const float* EEND = (const float*)(p.ws + WS_EEND);
    const bf16_t* MQg = (const bf16_t*)(p.ws + WS_MQK);
    const bf16_t* MKg = MQg + (size_t)RT * 512;
    const float* GATES = (const float*)(p.ws + WS_GATES);
    bf16_t* Obuf = (bf16_t*)(p.ws + WS_O);
    int tid = threadIdx.x; asm volatile("" : "+v"(tid));
    const int lane = tid & 63, wv = __builtin_amdgcn_readfirstlane(tid >> 6), fr = lane & 15, fq = lane >> 4;
    LAS bf16_t* QA = (LAS bf16_t*)(lds + SC_QA); LAS bf16_t* KA = (LAS bf16_t*)(lds + SC_KA); LAS bf16_t* KE = (LAS bf16_t*)(lds + SC_KE);
    LAS bf16_t* VT = (LAS bf16_t*)(lds + SC_VT); LAS bf16_t* PP = (LAS bf16_t*)(lds + SC_PP); LAS bf16_t* ST = (LAS bf16_t*)(lds + SC_ST);
    LAS float* AV = (LAS float*)(lds + SC_AV); LAS float* MJ = (LAS float*)(lds + SC_MJ); LAS float* INTER = (LAS float*)(lds + SC_INTER); LAS float* MQ = (LAS float*)(lds + SC_MQ);
    const LAS unsigned char* QAb = (const LAS unsigned char*)QA; const LAS unsigned char* KAb = (const LAS unsigned char*)KA; const LAS unsigned char* KEb = (const LAS unsigned char*)KE;
    const LAS unsigned char* VTb = (const LAS unsigned char*)VT; const LAS unsigned char* PPb = (const LAS unsigned char*)PP; const LAS unsigned char* STb = (const LAS unsigned char*)ST;
    const float qk_scale = 0.08838834764831845f;
    const short one_or_zero = (fr == 0) ? (short)0x3F80 : (short)0;
    const bf16x8 ones_frag = {one_or_zero, one_or_zero, one_or_zero, one_or_zero, one_or_zero, one_or_zero, one_or_zero, one_or_zero};
    const bf16x8 zero_frag = {0, 0, 0, 0, 0, 0, 0, 0};

    for (int item = blockIdx.x; item < 256; item += gridDim.x) {
        const int grp = item & 1, dir = (item >> 1) & 1, dvq = (item >> 2) & 3, h = (item >> 4) & 3, b = (item >> 6) & 3;
        __syncthreads();
        for (int i = tid; i < 66 * LD_QK / 2; i += 512) ((LAS unsigned*)ST)[i] = 0u;
        float bg_i = 0.f, bg_f = 0.f;
        if (grp == 1) { bg_i = p.mlstm_b_gate[((l * 2 + dir) * 2 + 0) * 4 + h]; bg_f = p.mlstm_b_gate[((l * 2 + dir) * 2 + 1) * 4 + h]; }
        f32x4 S[4], S5 = {0.f, 0.f, 0.f, 0.f};
#pragma unroll
        for (int q4 = 0; q4 < 4; ++q4) S[q4] = (f32x4){0.f, 0.f, 0.f, 0.f};
        float m_run = 0.f;
        const int qcol = ZC_MQ + h * 128 + wv * 16, kcol = ZC_MK + h * 128 + wv * 16;
        const int gqcol = h * 128 + wv * 16;
        const int vcol = (grp == 0 ? ZC_GV : ZC_MV) + h * 256 + dvq * 64 + wv * 8;
        const int ocol = grp * 1024 + h * 256 + dvq * 64;
        const int gcol_i = ZC_MG + dir * 8 + h, gcol_f = ZC_MG + dir * 8 + 4 + h;
        __syncthreads();

        auto load_step = [&](int s) -> ScanIn {
            ScanIn in;
            const bool is_ctx = s < 4;
            const int cch = is_ctx ? s : s - 4;
            const int nch = is_ctx ? (TC / 64) : (TL / 64);
            const int rowbase = is_ctx ? (RL + b * TC) : (b * TL);
            const int mc = dir ? (nch - 1 - cch) : cch;
            const int row = rowbase + mc * 64 + (dir ? 63 - lane : lane);
            const bf16_t* zr = Z + (size_t)row * PWP;
            in.vv = *(const u32x4*)(zr + vcol);
            in.gi = GATES[(size_t)((dir * 4 + h) * 3 + 0) * RT + row]; in.gf = GATES[(size_t)((dir * 4 + h) * 3 + 1) * RT + row]; in.ga = GATES[(size_t)((dir * 4 + h) * 3 + 2) * RT + row];
            const int gchunk = (rowbase >> 6) + mc;
            if (grp == 0) {
                const bf16_t* qr = QAg + (((size_t)dir * NCHUNK + gchunk) * 32 + h * 8 + wv) * 1024 + lane * 16;
                const bf16_t* kr = KAg + (((size_t)dir * NCHUNK + gchunk) * 32 + h * 8 + wv) * 1024 + lane * 16;
                in.q0 = *(const u32x4*)(qr); in.q1 = *(const u32x4*)(qr + 8);
                in.k0 = *(const u32x4*)(kr); in.k1 = *(const u32x4*)(kr + 8);
                in.ee = *(const f32x4*)(EEND + ((size_t)dir * NCHUNK + gchunk) * 512 + gqcol + fq * 4);
            } else {
                const int tm = dir ? 63 - lane : lane;
                const bf16_t* qr = MQg + ((size_t)gchunk * 32 + h * 8 + wv) * 1024 + tm * 16;
                const bf16_t* kr = MKg + ((size_t)gchunk * 32 + h * 8 + wv) * 1024 + tm * 16;
                in.q0 = *(const u32x4*)(qr); in.q1 = *(const u32x4*)(qr + 8);
                in.k0 = *(const u32x4*)(kr); in.k1 = *(const u32x4*)(kr + 8);
                in.ee = (f32x4){1.f, 1.f, 1.f, 1.f};
            }
            return in;
        };

        ScanIn cur = load_step(0);
        for (int s = 0; s < 68; ++s) {
            const bool is_ctx = s < 4;
            const int cch = is_ctx ? s : s - 4;
            const int nch = is_ctx ? (TC / 64) : (TL / 64);
            const int rowbase = is_ctx ? (RL + b * TC) : (b * TL);
            const int mc = dir ? (nch - 1 - cch) : cch;
            const bool want_out = (!is_ctx) || (l == 0);
            const int par = s & 1;
            LAS bf16_t* VTp = VT + par * (SC_VTB / 2); LAS bf16_t* PPp = PP + par * (SC_PPB / 2);
            const LAS unsigned char* VTpb = VTb + par * SC_VTB; const LAS unsigned char* PPpb = PPb + par * SC_PPB;
            const unsigned qw[8] = {cur.q0.x, cur.q0.y, cur.q0.z, cur.q0.w, cur.q1.x, cur.q1.y, cur.q1.z, cur.q1.w};
            const unsigned kw[8] = {cur.k0.x, cur.k0.y, cur.k0.z, cur.k0.w, cur.k1.x, cur.k1.y, cur.k1.z, cur.k1.w};
            float m_new = 0.f, cs = 1.f;
            unsigned kaw[8];
            if (grp == 0) {
#pragma unroll
                for (int e = 0; e < 8; ++e) {
                    const int ch = wv * 16 + 2 * e;
                    kaw[e] = kw[e];
                    KE[ch * LD_T + lane] = (bf16_t)(kw[e] & 0xffffu);
                    KE[(ch + 1) * LD_T + lane] = (bf16_t)(kw[e] >> 16);
                }
            } else {
                const float fcum = cur.gi, av = cur.gf, Aj = cur.ga;
                const float fend = rdlane63(fcum);
                const float amax = rdlane63(Aj);
                m_new = fmaxf(fend + m_run, fend + amax);
                cs = __expf(fend + m_run - m_new);
                const float wi = __expf(fend + av - m_new);
                const float Mj = fmaxf(m_run, Aj);
                if (wv == 0) { AV[lane] = av; MJ[lane] = Mj; INTER[lane] = __expf(m_run - Mj); MQ[lane] = fcum + Mj; }
#pragma unroll
                for (int e = 0; e < 8; ++e) {
                    const float k_lo = lo_bf(kw[e]), k_hi = hi_bf(kw[e]);
                    const int ch = wv * 16 + 2 * e;
                    kaw[e] = kw[e];
                    const unsigned ke = cvt_pk_bf16(wi * k_lo, wi * k_hi);
                    KE[ch * LD_T + lane] = (bf16_t)(ke & 0xffffu);
                    KE[(ch + 1) * LD_T + lane] = (bf16_t)(ke >> 16);
                }
            }
            { LAS u32x4* qd = (LAS u32x4*)(QA + lane * LD_QK + wv * 16); qd[0] = cur.q0; qd[1] = cur.q1;
              LAS u32x4* kd = (LAS u32x4*)(KA + lane * LD_QK + wv * 16); kd[0] = (u32x4){kaw[0], kaw[1], kaw[2], kaw[3]}; kd[1] = (u32x4){kaw[4], kaw[5], kaw[6], kaw[7]}; }
            { const unsigned vw[4] = {cur.vv.x, cur.vv.y, cur.vv.z, cur.vv.w};
#pragma unroll
              for (int e = 0; e < 4; ++e) { VTp[(wv * 8 + 2 * e) * LD_T + lane] = (bf16_t)(vw[e] & 0xffffu); VTp[(wv * 8 + 2 * e + 1) * LD_T + lane] = (bf16_t)(vw[e] >> 16); } }
            f32x4 ee_now = cur.ee;
            asm volatile("" : "+v"(ee_now));
            __syncthreads();
            __builtin_amdgcn_s_waitcnt(0x0F70);
            ScanIn nxt = load_step(s + 1 < 68 ? s + 1 : s);
            const int tj_o = wv & 3, j_o = tj_o * 16 + fr;
            f32x4 a2[2] = {{0.f, 0.f, 0.f, 0.f}, {0.f, 0.f, 0.f, 0.f}}, d2 = {0.f, 0.f, 0.f, 0.f};
            float rs = 1.f, emq = 0.f;
            const bf16x8 ak0 = lds_frag(KEb, wv * 16 + fr, LD_T, 0, fq), ak1 = lds_frag(KEb, wv * 16 + fr, LD_T, 1, fq);
            if (want_out) {
                const int t0 = wv * 2, tja = t0 >> 2, ti0 = t0 & 3, ti1 = ti0 + 1;
                const bool on0 = ti0 <= tja, on1 = ti1 <= tja;
                bf16x8 fq_[4], fk0[4], fk1[4];
#pragma unroll
                for (int kk = 0; kk < 4; ++kk) { fq_[kk] = lds_frag(QAb, tja * 16 + fr, LD_QK, kk, fq); fk0[kk] = lds_frag(KAb, ti0 * 16 + fr, LD_QK, kk, fq); fk1[kk] = lds_frag(KAb, ti1 * 16 + fr, LD_QK, kk, fq); }
                bf16x8 bq[4], fs0[4], fs1[4];
                const int tv0 = (wv >> 2) * 2;
#pragma unroll
                for (int kk = 0; kk < 4; ++kk) { bq[kk] = lds_frag(QAb, j_o, LD_QK, kk, fq); fs0[kk] = lds_frag(STb, tv0 * 16 + fr, LD_QK, kk, fq); fs1[kk] = lds_frag(STb, (tv0 + 1) * 16 + fr, LD_QK, kk, fq); }
                __builtin_amdgcn_sched_barrier(0);
                f32x4 acc0 = {0.f, 0.f, 0.f, 0.f}, acc1 = {0.f, 0.f, 0.f, 0.f};
                if (on0) {
#pragma unroll
                    for (int kk = 0; kk < 4; ++kk) acc0 = __builtin_amdgcn_mfma_f32_16x16x32_bf16(fk0[kk], fq_[kk], acc0, 0, 0, 0);
                }
                if (on1) {
#pragma unroll
                    for (int kk = 0; kk < 4; ++kk) acc1 = __builtin_amdgcn_mfma_f32_16x16x32_bf16(fk1[kk], fq_[kk], acc1, 0, 0, 0);
                }
                {
                    f32x4 a = {0.f, 0.f, 0.f, 0.f}, b = {0.f, 0.f, 0.f, 0.f};
#pragma unroll
                    for (int kk = 0; kk < 4; ++kk) { a = __builtin_amdgcn_mfma_f32_16x16x32_bf16(fs0[kk], bq[kk], a, 0, 0, 0); b = __builtin_amdgcn_mfma_f32_16x16x32_bf16(fs1[kk], bq[kk], b, 0, 0, 0); }
                    a2[0] = a; a2[1] = b;
                }
                if (grp == 1) {
                    bf16x8 n0 = lds_frag(STb, 64, LD_QK, 0, fq), n1 = lds_frag(STb, 64, LD_QK, 1, fq), n2 = lds_frag(STb, 64, LD_QK, 2, fq), n3 = lds_frag(STb, 64, LD_QK, 3, fq);
                    if (fr != 0) { n0 = zero_frag; n1 = zero_frag; n2 = zero_frag; n3 = zero_frag; }
                    d2 = __builtin_amdgcn_mfma_f32_16x16x32_bf16(n0, bq[0], d2, 0, 0, 0);
                    d2 = __builtin_amdgcn_mfma_f32_16x16x32_bf16(n1, bq[1], d2, 0, 0, 0);
                    d2 = __builtin_amdgcn_mfma_f32_16x16x32_bf16(n2, bq[2], d2, 0, 0, 0);
                    d2 = __builtin_amdgcn_mfma_f32_16x16x32_bf16(n3, bq[3], d2, 0, 0, 0);
                    rs = INTER[j_o]; emq = __expf(-MQ[j_o]);
                }
                {
                    const int j = tja * 16 + fr;
#pragma unroll
                    for (int tt = 0; tt < 2; ++tt) {
                        const int i0 = (ti0 + tt) * 16 + fq * 4; const f32x4 acc = tt ? acc1 : acc0;
                        float vals[4];
                        if (grp == 1) {
                            const f32x4 av4 = *(const LAS f32x4*)(AV + i0); const float mj = MJ[j];
#pragma unroll
                            for (int r = 0; r < 4; ++r) vals[r] = (i0 + r <= j) ? acc[r] * __expf(av4[r] - mj) : 0.f;
                        } else {
#pragma unroll
                            for (int r = 0; r < 4; ++r) vals[r] = (i0 + r <= j) ? acc[r] : 0.f;
                        }
                        u32x2 w; w.x = cvt_pk_bf16(vals[0], vals[1]); w.y = cvt_pk_bf16(vals[2], vals[3]);
                        *(LAS u32x2*)(PPp + j * LD_T + i0) = w;
                    }
                }
            }
            {
                bf16x8 fv[4][2];
#pragma unroll
                for (int tv = 0; tv < 4; ++tv) { fv[tv][0] = lds_frag(VTpb, tv * 16 + fr, LD_T, 0, fq); fv[tv][1] = lds_frag(VTpb, tv * 16 + fr, LD_T, 1, fq); }
                __builtin_amdgcn_sched_barrier(0);
#pragma unroll
                for (int tv = 0; tv < 4; ++tv) {
                    f32x4 a = S[tv] * cs;
                    a = __builtin_amdgcn_mfma_f32_16x16x32_bf16(ak0, fv[tv][0], a, 0, 0, 0);
                    a = __builtin_amdgcn_mfma_f32_16x16x32_bf16(ak1, fv[tv][1], a, 0, 0, 0);
                    S[tv] = a * ee_now;
                }
                if (grp == 1) {
                    f32x4 a = S5 * cs;
                    a = __builtin_amdgcn_mfma_f32_16x16x32_bf16(ak0, ones_frag, a, 0, 0, 0);
                    a = __builtin_amdgcn_mfma_f32_16x16x32_bf16(ak1, ones_frag, a, 0, 0, 0);
                    S5 = a;
                }
            }
            __syncthreads();
            {
#pragma unroll
                for (int tv = 0; tv < 4; ++tv) { u32x2 w; w.x = cvt_pk_bf16(S[tv][0], S[tv][1]); w.y = cvt_pk_bf16(S[tv][2], S[tv][3]);
                    *(LAS u32x2*)(ST + (tv * 16 + fr) * LD_QK + wv * 16 + fq * 4) = w; }
                if (grp == 1 && fr == 0) { u32x2 w; w.x = cvt_pk_bf16(S5[0], S5[1]); w.y = cvt_pk_bf16(S5[2], S5[3]);
                    *(LAS u32x2*)(ST + 64 * LD_QK + wv * 16 + fq * 4) = w; }
            }
            if (want_out) {
                const bf16x8 bp0 = lds_frag(PPpb, j_o, LD_T, 0, fq), bp1 = lds_frag(PPpb, j_o, LD_T, 1, fq);
                bf16x8 fvb[2][2];
#pragma unroll
                for (int tt = 0; tt < 2; ++tt) { const int tv = (wv >> 2) * 2 + tt; fvb[tt][0] = lds_frag(VTpb, tv * 16 + fr, LD_T, 0, fq); fvb[tt][1] = lds_frag(VTpb, tv * 16 + fr, LD_T, 1, fq); }
                __builtin_amdgcn_sched_barrier(0);
                float dn = 1.f;
                if (grp == 1) {
                    f32x4 d1 = {0.f, 0.f, 0.f, 0.f};
                    d1 = __builtin_amdgcn_mfma_f32_16x16x32_bf16(ones_frag, bp0, d1, 0, 0, 0);
                    d1 = __builtin_amdgcn_mfma_f32_16x16x32_bf16(ones_frag, bp1, d1, 0, 0, 0);
                    float den = d1[0] + rs * d2[0];
                    den = __int_as_float(__builtin_amdgcn_ds_bpermute(fr << 2, __float_as_int(den)));
                    dn = __builtin_amdgcn_rcpf(fmaxf(fabsf(den), emq));
                }
                const int rowj = rowbase + mc * 64 + (dir ? 63 - j_o : j_o);
#pragma unroll
                for (int tt = 0; tt < 2; ++tt) {
                    const int tv = (wv >> 2) * 2 + tt;
                    f32x4 a1 = {0.f, 0.f, 0.f, 0.f};
                    a1 = __builtin_amdgcn_mfma_f32_16x16x32_bf16(fvb[tt][0], bp0, a1, 0, 0, 0);
                    a1 = __builtin_amdgcn_mfma_f32_16x16x32_bf16(fvb[tt][1], bp1, a1, 0, 0, 0);
                    const f32x4 o = (a1 + rs * a2[tt]) * dn;
                    u32x2 w; w.x = cvt_pk_bf16(o[0], o[1]); w.y = cvt_pk_bf16(o[2], o[3]);
                    *(u32x2*)(Obuf + (size_t)dir * RT * DM + (size_t)rowj * DM + ocol + tv * 16 + fq * 4) = w;
                }
            }
            m_run = m_new;
            cur = nxt;
        }
    }
}

__global__ void __launch_bounds__(512, 2) mk_fwd(Params p) {
    extern __shared__ __attribute__((aligned(16))) unsigned char lds_raw[];
    LAS unsigned char* lds = (LAS unsigned char*)lds_raw;
    float* XB = (float*)(p.ws + WS_X);
    bf16_t* AB = (bf16_t*)(p.ws + WS_A);
    const float* MOD = (const float*)(p.ws + WS_MOD);
    int ph = 0;
    const int lo = (int)p.ph_lo, hi = (int)p.ph_hi;
#if !MULTI_LAUNCH
    if (lo < 0) cg::this_grid().sync();
    if (threadIdx.x < 4) ((LAS unsigned*)(lds + pg8::STAGE_BYTES))[threadIdx.x] = 0u;
    __syncthreads();
    const XcdBarrier gbar = xcd_barrier_post((unsigned*)(p.ws + WS_BAR), (volatile LAS unsigned*)(lds + pg8::STAGE_BYTES));
#endif
#define PHASE_BEGIN if (ph >= lo && ph < hi) {
#if MULTI_LAUNCH
#define PHASE_END } ++ph;
#else
#define PHASE_END } ++ph; if (ph > lo && ph < hi) xcd_barrier(gbar);
#endif
    PHASE_BEGIN
        for (int rep = 0; rep < REP_MISC; ++rep) { phase_mod(p, lds);
        __syncthreads(); }
        phase_wconv(p, 0, lds, 0, WC_T_IN, 0);
        phase_wconv(p, 0, lds, WC_T_IN + WC_TAIL0, WC_TOT, 0);
    PHASE_END
    for (int l = 0; l < NLAYER; ++l) {
        const float* modl = MOD + (size_t)l * 5 * MODW;
        const float* xl = l == 0 ? p.x : XB;
        const float* xc = l == 0 ? p.ctx : XB + (size_t)RL * DM;
        const int Mrows = l == 0 ? RT : RL;
        PHASE_BEGIN
            phase_norm(xl, xc, p.g_norm1 + l * DM, modl, 0, DM, RT, AB, l > 0 ? (const float*)(p.ws + WS_PART) : nullptr, XB + (size_t)RL * DM);
        PHASE_END
        PHASE_BEGIN
            pg8::Gemm g{AB, (const bf16_t*)(p.ws + WS_WIN), RT, PWP, DM, DM};
            pg8::StaticOrder S; S.init(RT, PWP, gridDim.x, blockIdx.x, DM);
            pg8::EpiBf16 E{(bf16_t*)(p.ws + WS_Z), PWP};
            for (int rep = 0; rep < REP_GEMM; ++rep) pg8::gemm_phase(lds, g, S, E);
            {
                const int nwg = (RT / 256) * (PWP / 256), extra = nwg % (int)gridDim.x;
                __syncthreads();
                if (l == 0) phase_wconv(p, 0, lds, WC_T_IN, WC_T_IN + WC_TAIL0, extra);
                else phase_wconv(p, l, lds, WC_NODN, WC_TOT, extra);
            }
        PHASE_END
        PHASE_BEGIN
#ifdef PROBE_CONV
            phase_decay(p, l, lds);
#endif
            phase_decay(p, l, lds);
        PHASE_END
        PHASE_BEGIN
            for (int rep = 0; rep < REP_SCAN; ++rep) phase_scan(p, l, lds);
        PHASE_END
        PHASE_BEGIN
            phase_merge(p, l, Mrows);
            if (l == 0) {
                const f32x4* src = (const f32x4*)p.ctx; f32x4* dst = (f32x4*)(XB + (size_t)RL * DM);
                for (int i = blockIdx.x * 512 + otid(); i < RC * DM / 4; i += gridDim.x * 512) dst[i] = src[i];
            }
        PHASE_END
        PHASE_BEGIN
            pg8::Gemm g{AB, (const bf16_t*)(p.ws + WS_WOUT), Mrows, DM, DM, DM};
            pg8::SplitTailOrder S; S.init(DM, gridDim.x, blockIdx.x, DM, l == 0);
            pg8::EpiRes E{xl, xc, XB, modl, 2 * DM, 1.0f, DM / 64, (float*)(p.ws + WS_PART)};
#ifdef PROBE_RES
            { pg8::EpiRes E0{xl, xc, XB, modl, 2 * DM, 0.0f, DM / 64, (float*)(p.ws + WS_PART)}; pg8::gemm_phase(lds, g, S, E0); }
#endif
            pg8::gemm_phase(lds, g, S, E);
        PHASE_END
        PHASE_BEGIN
            phase_norm(XB, XB + (size_t)RL * DM, p.g_norm2 + l * DM, modl, 3 * DM, 4 * DM, Mrows, AB, l == 0 ? (const float*)(p.ws + WS_PART) : nullptr, XB + (size_t)RL * DM);
        PHASE_END
        PHASE_BEGIN
            pg8::Gemm g{AB, (const bf16_t*)(p.ws + WS_WUP), Mrows, DFF2, DM, DM};
            pg8::StaticOrder S; S.init(Mrows, DFF2, gridDim.x, blockIdx.x, DM);
            pg8::EpiBf16 E{(bf16_t*)(p.ws + WS_UZ), DFF2};
            for (int rep = 0; rep < REP_GEMM; ++rep) pg8::gemm_phase(lds, g, S, E);
            if (l + 1 < NLAYER) {
                const int nwg = (Mrows / 256) * (DFF2 / 256), extra = nwg % (int)gridDim.x;
                __syncthreads();
                if (extra > 0) phase_wconv(p, l + 1, lds, 0, WC_T_IN + WC_T_OUT, extra);
                else phase_wconv(p, l + 1, lds, 0, WC_T_IN + WC_T_OUT, 0);
            }
        PHASE_END
        PHASE_BEGIN
#ifdef PROBE_CONV
            phase_conv(p, l, l == 0, true);
#endif
            phase_conv(p, l, l == 0);
        PHASE_END
        PHASE_BEGIN
            pg8::Gemm g{(const bf16_t*)(p.ws + WS_UZ) + DFF, (const bf16_t*)(p.ws + WS_WDN), Mrows, DM, DFF, DFF2};
            pg8::SplitTailOrder S; S.init(DM, gridDim.x, blockIdx.x, DFF, l == 0);
            pg8::EpiRes E{XB, XB + (size_t)RL * DM, XB, modl, 5 * DM, 1.0f, DFF / 64, (float*)(p.ws + WS_PART)};
#ifdef PROBE_RES
            { pg8::EpiRes E0{XB, XB + (size_t)RL * DM, XB, modl, 5 * DM, 0.0f, DFF / 64, (float*)(p.ws + WS_PART)}; pg8::gemm_phase(lds, g, S, E0); }
#endif
            pg8::gemm_phase(lds, g, S, E);
            if (l + 1 < NLAYER) {
                __syncthreads();
                phase_wconv(p, l + 1, lds, WC_T_IN + WC_T_OUT, WC_NODN, 0);
            }
        PHASE_END
    }
#ifdef EXTRA_SYNCS
    for (int i = 0; i < EXTRA_SYNCS; ++i) xcd_barrier(gbar);
#endif
    PHASE_BEGIN
        phase_final_norm(XB, p.g_final, p.out);
    PHASE_END
}
constexpr int N_PHASES = 1 + NLAYER * 10 + 1;

extern "C" void kernel_launch(void* const* d_in, const int* in_sizes, int n_in, void* d_out, int out_size, void* d_ws, size_t ws_size, hipStream_t stream) {
    static int grid = 0;
    if (grid == 0) {
        if (n_in != 20 || ws_size < WS_END) { fprintf(stderr, "kernel_launch: unexpected n_in %d or ws_size %zu (< %zu)\n", n_in, ws_size, (size_t)WS_END); grid = -1; return; }
        int dev = 0, cus = 0, per_cu = 0;
        hipGetDevice(&dev);
        hipDeviceGetAttribute(&cus, hipDeviceAttributeMultiprocessorCount, dev);
        if (hipFuncSetAttribute((const void*)mk_fwd, hipFuncAttributeMaxDynamicSharedMemorySize, LDS_BYTES) != hipSuccess) { fprintf(stderr, "kernel_launch: hipFuncSetAttribute failed\n"); grid = -1; return; }
        if (hipOccupancyMaxActiveBlocksPerMultiprocessor(&per_cu, (const void*)mk_fwd, 512, LDS_BYTES) != hipSuccess || per_cu < 1) { fprintf(stderr, "kernel_launch: occupancy query says %d\n", per_cu); per_cu = 1; }
        (void)hipGetLastError();
        grid = cus * 1;
        fprintf(stderr, "kernel_launch: cus %d per_cu %d grid %d ws %zu need %zu\n", cus, per_cu, grid, ws_size, (size_t)WS_END);
    }
    if (grid < 0) return;
    Params p{};
    const float** pp = (const float**)&p;
    for (int i = 0; i < 20; ++i) pp[i] = (const float*)d_in[i];
    p.out = (float*)d_out; p.ws = (unsigned char*)d_ws;
#if MULTI_LAUNCH
    for (int ph = 0; ph < N_PHASES; ++ph) {
        p.ph_lo = ph; p.ph_hi = ph + 1;
        hipLaunchKernelGGL(mk_fwd, dim3(grid), dim3(512), LDS_BYTES, stream, p);
    }
#else
    p.ph_lo = 0; p.ph_hi = N_PHASES;
    if (hipMemsetAsync((char*)d_ws + WS_BAR, 0, 16384, stream) != hipSuccess) { fprintf(stderr, "kernel_launch: memset of the barrier words failed\n"); return; }
    void* args[] = {&p};
    hipError_t e = hipLaunchCooperativeKernel((const void*)mk_fwd, dim3(grid), dim3(512), args, LDS_BYTES, stream);
    if (e != hipSuccess) fprintf(stderr, "cooperative launch failed: %s (grid %d)\n", hipGetErrorString(e), grid);
#endif
}
```

```cpp
#include <hip/hip_runtime.h>
#include <hip/hip_cooperative_groups.h>
#include <cstdio>
namespace cg = cooperative_groups;

#ifndef MULTI_LAUNCH
#define MULTI_LAUNCH 0
#endif


#ifndef REP_SCAN
#define REP_SCAN 1
#endif
#ifndef REP_GEMM
#define REP_GEMM 1
#endif
#ifndef REP_MISC
#define REP_MISC 1
#endif
#define LAS __attribute__((address_space(3)))
typedef unsigned short bf16_t;
typedef short bf16x8 __attribute__((ext_vector_type(8)));
typedef float f32x4 __attribute__((ext_vector_type(4)));
typedef unsigned u32x4 __attribute__((ext_vector_type(4)));
typedef unsigned u32x2 __attribute__((ext_vector_type(2)));

constexpr int DM = 2048, NB = 4, TL = 4096, TC = 256, NLAYER = 2;
constexpr int RL = NB * TL, RC = NB * TC, RT = RL + RC;
constexpr int PW = 6176, PWP = 6400, DFF = 5504, DFF2 = 11008;
constexpr int MODW = 6 * DM;
constexpr float EPS = 1e-6f;
constexpr int ZC_GQ = 0, ZC_GK = 512, ZC_GV = 1024, ZC_GG = 2048, ZC_MQ = 3072, ZC_MK = 3584, ZC_MV = 4096, ZC_MO = 5120, ZC_LR = 6144, ZC_MG = 6160;

constexpr size_t WS_UZ = 0;
constexpr size_t SZ_U = (size_t)RT * DFF2 * 2;
constexpr size_t WS_Z = WS_UZ;
constexpr size_t SZ_Z = (size_t)RT * PWP * 2;
constexpr size_t WS_O = WS_Z + SZ_Z;
constexpr size_t SZ_O1 = (size_t)RT * DM * 2;
static_assert(SZ_Z + 2 * SZ_O1 <= SZ_U, "overlay");
constexpr size_t WS_X = WS_UZ + SZ_U;
constexpr size_t WS_A = WS_X + (size_t)RT * DM * 4;
constexpr size_t WS_WIN = WS_A + (size_t)RT * DM * 2;
constexpr size_t WS_WOUT = WS_WIN + (size_t)PWP * DM * 2;
constexpr size_t WS_WUP = WS_WOUT + (size_t)DM * DM * 2;
constexpr size_t WS_WDN = WS_WUP + (size_t)DFF2 * DM * 2;
constexpr size_t WS_MOD = WS_WDN + (size_t)DM * DFF * 2;
constexpr size_t WS_BAR = WS_MOD + (size_t)NLAYER * 5 * MODW * 4;
constexpr size_t WS_EEND = WS_BAR + 16384;
constexpr size_t WS_PART = WS_EEND + (size_t)2 * (RT / 64) * 512 * 4;
constexpr size_t WS_MQK = WS_PART;
constexpr size_t SZ_MQK = (size_t)2 * RT * 512 * 2;
constexpr size_t WS_GATES = WS_PART + (SZ_MQK > (size_t)4 * RC * DM * 4 ? SZ_MQK : (size_t)4 * RC * DM * 4);
constexpr size_t WS_END = WS_GATES + (size_t)2 * 4 * 3 * RT * 4;

struct Params {
    const float *x, *c, *ctx, *c_ctx, *w_mod, *b_mod, *g_norm1, *g_norm2, *w_in, *gla_w_lr, *gla_b_lr, *mlstm_b_gate,
        *gla_g_norm, *mlstm_g_norm, *w_out, *w_up, *conv_w, *conv_b, *w_down, *g_final;
    float* out;
    unsigned char* ws;
    long long ph_lo, ph_hi;
};

__device__ __forceinline__ float bf2f(unsigned short h) { return __uint_as_float(((unsigned)h) << 16); }
__device__ __forceinline__ unsigned short f2bf(float f) { unsigned u = __float_as_uint(f); u += 0x7FFFu + ((u >> 16) & 1u); return (unsigned short)(u >> 16); }
typedef __bf16 bf16x2_t __attribute__((ext_vector_type(2)));
typedef float f32x2_t __attribute__((ext_vector_type(2)));
__device__ __forceinline__ unsigned cvt_pk_bf16(float lo, float hi) { const f32x2_t v = {lo, hi}; return __builtin_bit_cast(unsigned, __builtin_convertvector(v, bf16x2_t)); }
__device__ __forceinline__ float lo_bf(unsigned w) { return __uint_as_float(w << 16); }
__device__ __forceinline__ float hi_bf(unsigned w) { return __uint_as_float(w & 0xffff0000u); }
__device__ __forceinline__ float sigmoidf_(float x) { return __builtin_amdgcn_rcpf(1.0f + __expf(-x)); }
__device__ __forceinline__ float siluf_(float x) { return x * __builtin_amdgcn_rcpf(1.0f + __expf(-x)); }
__device__ __forceinline__ float logsigf_(float x) { return fminf(x, 0.f) - __logf(1.0f + __expf(-fabsf(x))); }
__device__ __forceinline__ int otid() { int t = threadIdx.x; asm volatile("" : "+v"(t)); return t; }
template <int CTRL, int RM> __device__ __forceinline__ float dpp_f(float v, float old) {
    return __int_as_float(__builtin_amdgcn_update_dpp(__float_as_int(old), __float_as_int(v), CTRL, RM, 0xF, false));
}
__device__ __forceinline__ float wave_incl_sum(float v) {
    v += dpp_f<0x111, 0xF>(v, 0.f); v += dpp_f<0x112, 0xF>(v, 0.f); v += dpp_f<0x114, 0xF>(v, 0.f); v += dpp_f<0x118, 0xF>(v, 0.f);
    v += dpp_f<0x142, 0xA>(v, 0.f); v += dpp_f<0x143, 0xC>(v, 0.f); return v;
}
__device__ __forceinline__ float wave_incl_max(float v) {
    const float ninf = __int_as_float(0xff800000);
    v = fmaxf(v, dpp_f<0x111, 0xF>(v, ninf)); v = fmaxf(v, dpp_f<0x112, 0xF>(v, ninf)); v = fmaxf(v, dpp_f<0x114, 0xF>(v, ninf)); v = fmaxf(v, dpp_f<0x118, 0xF>(v, ninf));
    v = fmaxf(v, dpp_f<0x142, 0xA>(v, ninf)); v = fmaxf(v, dpp_f<0x143, 0xC>(v, ninf)); return v;
}
__device__ __forceinline__ float rdlane63(float v) { return __int_as_float(__builtin_amdgcn_readlane(__float_as_int(v), 63)); }
__device__ __forceinline__ float wave_sum(float v) { return rdlane63(wave_incl_sum(v)); }
__device__ __forceinline__ float wave_max(float v) { return rdlane63(wave_incl_max(v)); }


#define XB_TMO      128
#define XB_XCNT(j)  (256  + 64 * (j))
#define XB_XSUB(j)  (1280 + 64 * (j))
#define XB_XGEN(j)  (2304 + 64 * (j))
#define XB_TOP      3328
#define XB_TOPGEN   3392
#define XCD_BAR_WORDS 3456
#define XB_SPIN_CAP (1u << 22)
__device__ __forceinline__ unsigned xb_ld(unsigned* p)              { return __hip_atomic_load(p, __ATOMIC_RELAXED, __HIP_MEMORY_SCOPE_AGENT); }
__device__ __forceinline__ unsigned xb_add(unsigned* p, unsigned v) { return __hip_atomic_fetch_add(p, v, __ATOMIC_RELAXED, __HIP_MEMORY_SCOPE_AGENT); }
__device__ __forceinline__ unsigned xb_xcc_id() { return (unsigned)__builtin_amdgcn_s_getreg((3 << 11) | 20) & 0xFu; }
#define XB_SPIN(cond, bar) do { unsigned _sp = 0; while (cond) { __builtin_amdgcn_s_sleep(1); \
    if ((++_sp & 255u) == 0u) { if (xb_ld(&(bar)[XB_TMO])) break; if (_sp > XB_SPIN_CAP) { atomicAdd(&(bar)[XB_TMO], 1u); break; } } } } while (0)
struct XcdBarrier { unsigned* bar; unsigned x; volatile LAS unsigned* st; };
__device__ __forceinline__ XcdBarrier xcd_barrier_post(unsigned* bar, volatile LAS unsigned* st) {
    XcdBarrier b; b.bar = bar; b.x = xb_xcc_id(); b.st = st;
    if (threadIdx.x == 0) (void)xb_add(&bar[XB_XCNT(b.x)], 1u);
    return b;
}
__device__ __forceinline__ void xcd_barrier_complete(unsigned* bar, unsigned x, unsigned& nloc, unsigned& nx) {
    const unsigned G = gridDim.x * gridDim.y * gridDim.z;
    unsigned sum, cnt, mine, sp = 0u;
    for (;;) {
        sum = 0u; cnt = 0u; mine = 0u;
#pragma unroll
        for (unsigned j = 0; j < 16; ++j) { const unsigned c = xb_ld(&bar[XB_XCNT(j)]); sum += c; cnt += (c > 0u) ? 1u : 0u; mine = (j == x) ? c : mine; }
        if (sum == G) break;
        __builtin_amdgcn_s_sleep(1);
        if ((++sp & 255u) == 0u) { if (xb_ld(&bar[XB_TMO])) break; if (sp > XB_SPIN_CAP) { atomicAdd(&bar[XB_TMO], 1u); break; } }
    }
    nloc = mine > 0u ? mine : 1u; nx = cnt > 0u ? cnt : 1u;
}
__device__ __forceinline__ void xcd_barrier(const XcdBarrier& b) {
    asm volatile("s_waitcnt vmcnt(0)" ::: "memory");
    __syncthreads();
    if (threadIdx.x == 0) {
        unsigned* bar = b.bar;
        __builtin_amdgcn_s_waitcnt(0);
        unsigned nloc = b.st[0], nx = b.st[1];
        if (nloc == 0u) { xcd_barrier_complete(bar, b.x, nloc, nx); b.st[0] = nloc; b.st[1] = nx; }
        const unsigned old = xb_add(&bar[XB_XSUB(b.x)], 1u);
        const unsigned gen = old / nloc;
        if (old + 1u == (gen + 1u) * nloc) {
            __builtin_amdgcn_fence(__ATOMIC_RELEASE, "agent");
            asm volatile("s_waitcnt vmcnt(0)" ::: "memory");
            const unsigned og = xb_add(&bar[XB_TOP], 1u);
            const unsigned tg = og / nx;
            if (og + 1u == (tg + 1u) * nx) xb_add(&bar[XB_TOPGEN], 1u);
            else XB_SPIN(xb_ld(&bar[XB_TOPGEN]) == tg, bar);
            __builtin_amdgcn_fence(__ATOMIC_ACQUIRE, "agent");
            xb_add(&bar[XB_XGEN(b.x)], 1u);
            asm volatile("s_waitcnt vmcnt(0)" ::: "memory");
        } else {
            XB_SPIN(xb_ld(&bar[XB_XGEN(b.x)]) == gen, bar);
            __builtin_amdgcn_fence(__ATOMIC_ACQUIRE, "agent");
            asm volatile("s_waitcnt vmcnt(0)" ::: "memory");
        }
    }
    __syncthreads();
}

namespace pg8 {
constexpr int BM = 256, BK = 64, HALF = 128, HTB = HALF * BK * 2, STAGE_BYTES = 8 * HTB, NXCD = 8, WGM = 4;
__host__ __device__ __forceinline__ int lds_byte(int r, int c) { const int st = (r >> 4) * 2 + (c >> 5), rr = r & 15, cc = c & 31, ob = rr * 64 + cc * 2; return st * 1024 + (ob ^ (((ob >> 9) & 1) << 5)); }
__host__ __device__ __forceinline__ void stage_rc(int b, int& R, int& C) { const int st = b / 1024, sb = b % 1024, swz = sb ^ (((sb >> 9) & 1) << 5); R = (st >> 1) * 16 + swz / 64; C = (st & 1) * 32 + (swz % 64) / 2; }
__host__ __device__ __forceinline__ int perm32(int rho) { const int n = rho >> 4, i = rho & 15; return 8 * (i >> 2) + 4 * n + (i & 3); }
struct Unit { int pm, pn, kt0, nt, piece; };
struct Gemm { const bf16_t* A; const bf16_t* Bt; int M, N, K, lda; };
struct StaticOrder {
    int nM, nN, nwg, G, c, ntK;
    __host__ __device__ void init(int M, int N, int G_, int c_, int K_ = 0) { nM = M / BM; nN = N / BM; nwg = nM * nN; G = G_; c = c_; ntK = K_ / BK; }
    __host__ __device__ bool next(int i, Unit& u) const {
        const long L = (long)i * G + c; if (L >= nwg) return false;
        int wgid = (int)L;
#ifndef NO_XCD_REMAP
        { const int q = nwg / NXCD, r = nwg % NXCD, xcd = wgid % NXCD, off = wgid / NXCD; wgid = (xcd < r ? xcd * (q + 1) : r * (q + 1) + (xcd - r) * q) + off; }
#endif
        const int nig = WGM * nN, gid = wgid / nig, fm = gid * WGM, gsz = (nM - fm) < WGM ? (nM - fm) : WGM;
        u.pm = fm + ((wgid % nig) % gsz); u.pn = (wgid % nig) / gsz; u.kt0 = 0; u.nt = ntK; u.piece = 0; return true;
    }
};
struct SplitTailOrder {
    StaticOrder lat; int ntK, nlat, npieces;
    __host__ __device__ void init(int N, int G_, int c_, int K_, bool with_ctx) { lat.init(RL, N, G_, c_, K_); ntK = K_ / BK; nlat = lat.nwg; npieces = with_ctx ? 32 * 4 : 0; }
    __host__ __device__ bool next(int i, Unit& u) const {
        const long L = (long)i * lat.G + lat.c;
        u.pm = 0; u.pn = 0; u.kt0 = 0; u.nt = ntK; u.piece = 0;
        if (L < nlat) { Unit t; t.pm = 0; t.pn = 0; t.kt0 = 0; t.nt = ntK; t.piece = 0; const bool ok = lat.next(i, t); u.pm = t.pm; u.pn = t.pn; return ok; }
        const int q = (int)(L - nlat); if (q >= npieces) return false;
        const int uu = q >> 2, piece = q & 3;
        u.pm = 64 + (uu >> 3); u.pn = uu & 7; u.piece = piece;
        const int nb = ntK / 2;
        const int base = nb / 4, rem = nb % 4;
        const int b0 = piece * base + (piece < rem ? piece : rem), nbp = base + (piece < rem ? 1 : 0);
        u.kt0 = 2 * b0; u.nt = 2 * nbp; return true;
    }
};

struct EpiBf16 {
    static constexpr bool PERM = true;
    bf16_t* O; int ldc;
    __device__ __forceinline__ void operator()(const f32x4 (&acc)[2][2][4][2], const Unit& u, int wr, int wc, int fr, int fq) const {
        const int row0 = u.pm * BM + wr * 64 + fr; const int col0 = u.pn * BM + wc * 32 + 8 * fq;
#pragma unroll
        for (int ai = 0; ai < 2; ++ai)
#pragma unroll
            for (int m = 0; m < 4; ++m) { bf16_t* rowp = O + (size_t)(row0 + ai * HALF + m * 16) * ldc + col0;
#pragma unroll
                for (int bj = 0; bj < 2; ++bj) { const f32x4 v0 = acc[ai][bj][m][0], v1 = acc[ai][bj][m][1];
                    u32x4 w; w.x = cvt_pk_bf16(v0[0], v0[1]); w.y = cvt_pk_bf16(v0[2], v0[3]); w.z = cvt_pk_bf16(v1[0], v1[1]); w.w = cvt_pk_bf16(v1[2], v1[3]);
                    *(u32x4*)(rowp + bj * HALF) = w; } }
    }
};
struct EpiRes {
    static constexpr bool PERM = false;
    const float* base_lat; const float* base_ctx; float* out; const float* mod; int gt_off; float scale; int ntK; float* part;
    __device__ __forceinline__ void operator()(const f32x4 (&acc)[2][2][4][2], const Unit& u, int wr, int wc, int fr, int fq) const {
        const int bidx = u.pm < 64 ? (u.pm >> 4) : 4;
        const bool split = u.nt < ntK;
        const float* gt = mod + (size_t)bidx * MODW + gt_off;
        const int row0 = u.pm * BM + wr * 64 + fr, col0 = u.pn * BM + wc * 32 + 4 * fq;
        const float* bbase = u.pm < 64 ? base_lat : (base_ctx - (size_t)RL * DM);
        f32x4 gv[2][2];
#pragma unroll
        for (int bj = 0; bj < 2; ++bj)
#pragma unroll
            for (int n = 0; n < 2; ++n) gv[bj][n] = *(const f32x4*)(gt + col0 + bj * HALF + n * 16) * scale;
        if (split) {
#pragma unroll
            for (int ai = 0; ai < 2; ++ai)
#pragma unroll
                for (int m = 0; m < 4; ++m) { const size_t off = (size_t)(row0 + ai * HALF + m * 16) * DM + col0;
#pragma unroll
                    for (int bj = 0; bj < 2; ++bj)
#pragma unroll
                        for (int n = 0; n < 2; ++n) *(f32x4*)(part + (size_t)u.piece * RC * DM + (off - (size_t)RL * DM) + bj * HALF + n * 16) = gv[bj][n] * acc[ai][bj][m][n]; }
        } else {
#pragma unroll
            for (int ai = 0; ai < 2; ++ai)
                {
                    f32x4 bs[4][2][2];
#pragma unroll
                    for (int mm = 0; mm < 4; ++mm) { const size_t off = (size_t)(row0 + ai * HALF + mm * 16) * DM + col0;
#pragma unroll
                        for (int bj = 0; bj < 2; ++bj)
#pragma unroll
                            for (int n = 0; n < 2; ++n) bs[mm][bj][n] = *(const f32x4*)(bbase + off + bj * HALF + n * 16); }
#pragma unroll
                    for (int mm = 0; mm < 4; ++mm) { const size_t off = (size_t)(row0 + ai * HALF + mm * 16) * DM + col0;
#pragma unroll
                        for (int bj = 0; bj < 2; ++bj)
#pragma unroll
                            for (int n = 0; n < 2; ++n) *(f32x4*)(out + off + bj * HALF + n * 16) = bs[mm][bj][n] + gv[bj][n] * acc[ai][bj][mm][n]; }
                    asm volatile("" ::: "memory"); }
        }
        __builtin_amdgcn_s_waitcnt(0x0F70);
    }
};

#ifndef PG8_SP2
#define PG8_SP2 true
#endif
#ifndef PG8_ALIGN
#define PG8_ALIGN true
#endif
template <class Epi, class Sched, bool SP2 = PG8_SP2, bool ALIGN_EPI = PG8_ALIGN>
__device__ __forceinline__ void gemm_phase(LAS unsigned char* lds, const Gemm g, const Sched& S, const Epi& E) {
    int tid = threadIdx.x; asm volatile("" : "+v"(tid));
    const int wid = __builtin_amdgcn_readfirstlane(tid >> 6), lane = tid & 63, wr = wid >> 2, wc = wid & 3, fr = lane & 15, fq = lane >> 4;
    const int K = g.K, lda = g.lda;
    unsigned voffA[2], voffB[2];
#pragma unroll
    for (int i = 0; i < 2; ++i) { int R, C; stage_rc(tid * 16 + i * 8192, R, C); const int Rb = Epi::PERM ? ((R & ~31) + perm32(R & 31)) : R;
        voffA[i] = (unsigned)(R * lda + C) * 2u; voffB[i] = (unsigned)(Rb * K + C) * 2u; }
    const size_t kstep = (size_t)(BK * 2);
    const size_t hstepA = (size_t)HALF * lda * 2, hstepB = (size_t)HALF * K * 2;
    const size_t tstepA = 2 * hstepA, tstepB = 2 * hstepB;
    const unsigned ldsw = (unsigned)wid * 1024u;
    const int aoff = lds_byte(wr * 64 + fr, fq * 8), boff = lds_byte(wc * 32 + fr, fq * 8);
#define PG8_SA(b, h) (((b) * 2 + (h)) * HTB)
#define PG8_SB(b, h) ((4 + (b) * 2 + (h)) * HTB)
#define PG8_STAGE(bufoff, gbase, voff) do { _Pragma("unroll") for (int _i = 0; _i < 2; ++_i) \
        __builtin_amdgcn_global_load_lds((const unsigned*)((const char*)(gbase) + (voff)[_i]), (LAS unsigned*)(lds + (bufoff) + ldsw + _i * 8192), 16, 0, 0); } while (0)
#define PG8_LDA(dst, b, h) do { _Pragma("unroll") for (int m = 0; m < 4; ++m) _Pragma("unroll") for (int k = 0; k < 2; ++k) dst[m][k] = *(const LAS bf16x8*)(lds + PG8_SA(b, h) + aoff + m * 2048 + k * 1024); } while (0)
#define PG8_LDB(dst, b, h) do { _Pragma("unroll") for (int n = 0; n < 2; ++n) _Pragma("unroll") for (int k = 0; k < 2; ++k) dst[n][k] = *(const LAS bf16x8*)(lds + PG8_SB(b, h) + boff + n * 2048 + k * 1024); } while (0)
#define PG8_MMA(ai, bj, At, Bt) do { __builtin_amdgcn_s_setprio(1); _Pragma("unroll") for (int m = 0; m < 4; ++m) _Pragma("unroll") for (int n = 0; n < 2; ++n) _Pragma("unroll") for (int k = 0; k < 2; ++k) \
        acc[ai][bj][m][n] = __builtin_amdgcn_mfma_f32_16x16x32_bf16(Bt[n][k], At[m][k], acc[ai][bj][m][n], 0, 0, 0); __builtin_amdgcn_s_setprio(0); } while (0)
#define PG8_WAIT_V(n) asm volatile("s_waitcnt vmcnt(" #n ")" ::: "memory")
#define PG8_WAIT_L(n) asm volatile("s_waitcnt lgkmcnt(" #n ")" ::: "memory")
#define PG8_BAR __builtin_amdgcn_s_barrier()
#define PG8_SCHED __builtin_amdgcn_sched_barrier(0)
    Unit cur, nxt; int ui = 0;
    if (!S.next(0, cur)) return;
    f32x4 acc[2][2][4][2];
#pragma unroll
    for (int a = 0; a < 2; ++a)
#pragma unroll
        for (int b = 0; b < 2; ++b)
#pragma unroll
            for (int m = 0; m < 4; ++m)
#pragma unroll
                for (int n = 0; n < 2; ++n) acc[a][b][m][n] = (f32x4){0.f, 0.f, 0.f, 0.f};
    bf16x8 At[4][2], B0[2][2], B1[2][2];
    const char* cA = (const char*)g.A + (size_t)cur.pm * tstepA + (size_t)cur.kt0 * kstep; const char* cB = (const char*)g.Bt + (size_t)cur.pn * tstepB + (size_t)cur.kt0 * kstep;
    if constexpr (SP2) {
        PG8_STAGE(PG8_SB(0, 0), cB, voffB); PG8_STAGE(PG8_SB(0, 1), cB + hstepB, voffB); PG8_STAGE(PG8_SA(0, 0), cA, voffA); PG8_STAGE(PG8_SA(0, 1), cA + hstepA, voffA);
        if (wr == 1) PG8_BAR;
        PG8_WAIT_V(2); PG8_BAR;
        PG8_STAGE(PG8_SB(1, 0), cB + kstep, voffB); PG8_STAGE(PG8_SA(1, 0), cA + kstep, voffA); PG8_STAGE(PG8_SB(1, 1), cB + hstepB + kstep, voffB);
        PG8_WAIT_V(6); PG8_BAR;
    } else {
    PG8_STAGE(PG8_SB(0, 0), cB, voffB); PG8_STAGE(PG8_SA(0, 0), cA, voffA); PG8_STAGE(PG8_SB(0, 1), cB + hstepB, voffB); PG8_STAGE(PG8_SA(0, 1), cA + hstepA, voffA);
    if (wr == 1) PG8_BAR;
    PG8_WAIT_V(4); PG8_BAR;
    PG8_STAGE(PG8_SB(1, 0), cB + kstep, voffB); PG8_STAGE(PG8_SA(1, 0), cA + kstep, voffA); PG8_STAGE(PG8_SB(1, 1), cB + hstepB + kstep, voffB);
    PG8_WAIT_V(6); PG8_BAR;
    }
    for (;;) {
        const bool has_next = S.next(ui + 1, nxt);
        const char* nA = has_next ? (const char*)g.A + (size_t)nxt.pm * tstepA + (size_t)nxt.kt0 * kstep : cA; const char* nB = has_next ? (const char*)g.Bt + (size_t)nxt.pn * tstepB + (size_t)nxt.kt0 * kstep : cB;
        const int nt = cur.nt;
        for (int t = 0; t < nt; t += 2) {
            const bool last = (t == nt - 2);
            const char* a1 = cA + (size_t)(t + 1) * kstep;
            const char* a2 = last ? nA : cA + (size_t)(t + 2) * kstep; const char* b2 = last ? nB : cB + (size_t)(t + 2) * kstep;
            const char* a3 = a2 + kstep; const char* b3 = b2 + kstep;
            if constexpr (SP2) {
            PG8_LDB(B0, 0, 0); PG8_LDB(B1, 0, 1); PG8_SCHED; PG8_LDA(At, 0, 0); PG8_STAGE(PG8_SA(1, 1), a1 + hstepA, voffA);
            PG8_WAIT_V(8); PG8_WAIT_L(0); PG8_BAR; PG8_MMA(0, 0, At, B0); PG8_MMA(0, 1, At, B1); PG8_BAR; PG8_SCHED;
            PG8_LDA(At, 0, 1); PG8_STAGE(PG8_SB(0, 0), b2, voffB); PG8_STAGE(PG8_SB(0, 1), b2 + hstepB, voffB); PG8_STAGE(PG8_SA(0, 0), a2, voffA);
            PG8_WAIT_V(8); PG8_WAIT_L(0); PG8_BAR; PG8_MMA(1, 0, At, B0); PG8_MMA(1, 1, At, B1); PG8_BAR; PG8_SCHED;
            PG8_LDB(B0, 1, 0); PG8_LDB(B1, 1, 1); PG8_SCHED; PG8_LDA(At, 1, 0); PG8_STAGE(PG8_SA(0, 1), a2 + hstepA, voffA);
            PG8_WAIT_V(8); PG8_WAIT_L(0); PG8_BAR; PG8_MMA(0, 0, At, B0); PG8_MMA(0, 1, At, B1); PG8_BAR; PG8_SCHED;
            PG8_LDA(At, 1, 1); PG8_STAGE(PG8_SB(1, 0), b3, voffB); PG8_STAGE(PG8_SB(1, 1), b3 + hstepB, voffB); PG8_STAGE(PG8_SA(1, 0), a3, voffA);
            PG8_WAIT_V(8); PG8_WAIT_L(0); PG8_BAR; PG8_MMA(1, 0, At, B0); PG8_MMA(1, 1, At, B1); PG8_BAR; PG8_SCHED;
            } else {
            PG8_LDB(B0, 0, 0); PG8_SCHED; PG8_LDA(At, 0, 0); PG8_STAGE(PG8_SA(1, 1), a1 + hstepA, voffA);
            PG8_WAIT_L(8); PG8_BAR; PG8_WAIT_L(0); PG8_MMA(0, 0, At, B0); PG8_BAR; PG8_SCHED;
            PG8_LDB(B1, 0, 1); PG8_STAGE(PG8_SB(0, 0), b2, voffB);
            PG8_BAR; PG8_WAIT_L(0); PG8_MMA(0, 1, At, B1); PG8_BAR;
            PG8_LDA(At, 0, 1); PG8_STAGE(PG8_SA(0, 0), a2, voffA);
            PG8_BAR; PG8_WAIT_L(0); PG8_MMA(1, 0, At, B0); PG8_BAR; PG8_SCHED;
            PG8_STAGE(PG8_SB(0, 1), b2 + hstepB, voffB);
            PG8_WAIT_V(6); PG8_BAR; PG8_MMA(1, 1, At, B1); PG8_BAR;
            PG8_LDB(B0, 1, 0); PG8_SCHED; PG8_LDA(At, 1, 0); PG8_STAGE(PG8_SA(0, 1), a2 + hstepA, voffA);
            PG8_WAIT_L(8); PG8_BAR; PG8_WAIT_L(0); PG8_MMA(0, 0, At, B0); PG8_BAR; PG8_SCHED;
            PG8_LDB(B1, 1, 1); PG8_STAGE(PG8_SB(1, 0), b3, voffB);
            PG8_BAR; PG8_WAIT_L(0); PG8_MMA(0, 1, At, B1); PG8_BAR;
            PG8_LDA(At, 1, 1); PG8_STAGE(PG8_SA(1, 0), a3, voffA);
            PG8_BAR; PG8_WAIT_L(0); PG8_MMA(1, 0, At, B0); PG8_BAR; PG8_SCHED;
            PG8_STAGE(PG8_SB(1, 1), b3 + hstepB, voffB);
            PG8_WAIT_V(6); PG8_BAR; PG8_MMA(1, 1, At, B1); PG8_BAR;
            }
        }
        if constexpr (ALIGN_EPI) { if (wr == 0) PG8_BAR; }
        E(acc, cur, wr, wc, fr, fq);
        if (!has_next) break;
#pragma unroll
        for (int a = 0; a < 2; ++a)
#pragma unroll
            for (int b = 0; b < 2; ++b)
#pragma unroll
                for (int m = 0; m < 4; ++m)
#pragma unroll
                    for (int n = 0; n < 2; ++n) acc[a][b][m][n] = (f32x4){0.f, 0.f, 0.f, 0.f};
        cur = nxt; cA = nA; cB = nB; ++ui;
        if constexpr (ALIGN_EPI) { if (wr == 1) PG8_BAR; }
    }
    PG8_WAIT_V(0);
    if constexpr (!ALIGN_EPI) { if (wr == 0) PG8_BAR; }
    PG8_BAR;
#undef PG8_SA
#undef PG8_SB
#undef PG8_STAGE
#undef PG8_LDA
#undef PG8_LDB
#undef PG8_MMA
#undef PG8_WAIT_V
#undef PG8_WAIT_L
#undef PG8_BAR
#undef PG8_SCHED
}
}

constexpr int LDS_BYTES = pg8::STAGE_BYTES + 16;

__device__ __forceinline__ void phase_mod(const Params& p, LAS unsigned char* lds) {
    LAS float* act = (LAS float*)lds;
    LAS float* part = (LAS float*)(lds + 40960);
    const int tid = otid();
    for (int i = tid; i < 5 * DM; i += 512) { const int r = i / DM, k = i % DM; const float v = r < 4 ? p.c[r * DM + k] : p.c_ctx[k]; act[i] = siluf_(v); }
    __syncthreads();
    float* modout = (float*)(p.ws + WS_MOD);
    for (int unit = blockIdx.x; unit < 2 * 128; unit += gridDim.x) {
        const int l = unit >> 7, n0 = (unit & 127) * 96;
        const int c4 = tid % 24, kg = tid / 24;
        f32x4 a0 = {0, 0, 0, 0}, a1 = a0, a2 = a0, a3 = a0, a4 = a0;
        if (kg < 21) {
            const float* wp = p.w_mod + (size_t)l * DM * MODW + n0 + c4 * 4;
            for (int k0 = kg; k0 < DM; k0 += 21 * 7) {
                f32x4 w[7]; int kk[7]; float ok[7];
#pragma unroll
                for (int u = 0; u < 7; ++u) { const int k = k0 + 21 * u; const bool in = k < DM; kk[u] = in ? k : kg; ok[u] = in ? 1.0f : 0.0f; w[u] = *(const f32x4*)(wp + (size_t)kk[u] * MODW); }
#pragma unroll
                for (int u = 0; u < 7; ++u) { const f32x4 wu = w[u] * ok[u]; const int k = kk[u];
                    a0 += act[k] * wu; a1 += act[DM + k] * wu; a2 += act[2 * DM + k] * wu; a3 += act[3 * DM + k] * wu; a4 += act[4 * DM + k] * wu; }
            }
            LAS float* pp = part + kg * 480 + c4 * 4;
            *(LAS f32x4*)(pp) = a0; *(LAS f32x4*)(pp + 96) = a1; *(LAS f32x4*)(pp + 192) = a2; *(LAS f32x4*)(pp + 288) = a3; *(LAS f32x4*)(pp + 384) = a4;
        }
        __syncthreads();
        if (tid < 480) {
            const int r = tid / 96, cc = tid % 96; float s = p.b_mod[l * MODW + n0 + cc];
            for (int g = 0; g < 21; ++g) s += part[g * 480 + tid];
            modout[((size_t)l * 5 + r) * MODW + n0 + cc] = s;
        }
        __syncthreads();
    }
}

__device__ __forceinline__ void wconv_tile(const float* src, bf16_t* dst, int K, int N, int k0, int n0, bool is_win, LAS float* tile) {
    const int tid = otid();
    {
        const int r = tid >> 4, c4 = tid & 15;
        f32x4 v[4][2];
#pragma unroll
        for (int j = 0; j < 4; ++j) {
            const int n = n0 + j * 64 + c4 * 4; int on = n;
            if (is_win) { if (n >= 6176) on = -1; else if (n >= 6160) on = n; else if (n >= 6144) on = 3072 + (n - 6144); else if (n >= 3072) on = n + 16; }
#pragma unroll
            for (int rr = 0; rr < 2; ++rr) {
                v[j][rr] = (f32x4){0.f, 0.f, 0.f, 0.f};
                if (on >= 0) v[j][rr] = *(const f32x4*)(src + (size_t)(k0 + r + rr * 32) * N + on);
            }
        }
#pragma unroll
        for (int j = 0; j < 4; ++j)
#pragma unroll
            for (int rr = 0; rr < 2; ++rr) {
                const int k = r + rr * 32; LAS float* tp = tile + (j * 64 + c4 * 4) * 65 + k;
                tp[0] = v[j][rr][0]; tp[65] = v[j][rr][1]; tp[130] = v[j][rr][2]; tp[195] = v[j][rr][3];
            }
    }
    __syncthreads();
#pragma unroll
    for (int q = 0; q < 4; ++q) {
        const int n = q * 64 + (tid >> 3), seg = tid & 7;
        const LAS float* tp = tile + n * 65 + seg * 8;
        u32x4 w; w.x = cvt_pk_bf16(tp[0], tp[1]); w.y = cvt_pk_bf16(tp[2], tp[3]); w.z = cvt_pk_bf16(tp[4], tp[5]); w.w = cvt_pk_bf16(tp[6], tp[7]);
        *(u32x4*)(dst + (size_t)(n0 + n) * K + k0 + seg * 8) = w;
    }
    __syncthreads();
}
constexpr int WC_T_IN = 32 * 25, WC_T_OUT = 32 * 8, WC_T_UP = 32 * 43, WC_T_DN = 86 * 8;
constexpr int WC_TOT = WC_T_IN + WC_T_OUT + WC_T_UP + WC_T_DN, WC_NODN = WC_T_IN + WC_T_OUT + WC_T_UP, WC_TAIL0 = 600;
__device__ __forceinline__ void phase_wconv(const Params& p, int l, LAS unsigned char* lds, int t_begin = 0, int t_end = WC_TOT, int first_block = 0) {
    LAS float* tile = (LAS float*)lds;
    constexpr int T_IN = WC_T_IN, T_OUT = WC_T_OUT, T_UP = WC_T_UP;
    if ((int)blockIdx.x < first_block) return;
    for (int t = t_begin + (int)blockIdx.x - first_block; t < t_end; t += (int)gridDim.x - first_block) {
        if (t < T_IN) { const int kt = t % 32, ntile = t / 32; wconv_tile(p.w_in + (size_t)l * DM * PW, (bf16_t*)(p.ws + WS_WIN), DM, PW, kt * 64, ntile * 256, true, tile); }
        else if (t < T_IN + T_OUT) { const int u = t - T_IN; const int kt = u % 32, ntile = u / 32; wconv_tile(p.w_out + (size_t)l * DM * DM, (bf16_t*)(p.ws + WS_WOUT), DM, DM, kt * 64, ntile * 256, false, tile); }
        else if (t < T_IN + T_OUT + T_UP) { const int u = t - T_IN - T_OUT; const int kt = u % 32, ntile = u / 32; wconv_tile(p.w_up + (size_t)l * DM * DFF2, (bf16_t*)(p.ws + WS_WUP), DM, DFF2, kt * 64, ntile * 256, false, tile); }
        else { const int u = t - T_IN - T_OUT - T_UP; const int kt = u % 86, ntile = u / 86; wconv_tile(p.w_down + (size_t)l * DFF * DM, (bf16_t*)(p.ws + WS_WDN), DFF, DM, kt * 64, ntile * 256, false, tile); }
    }
}

__device__ __forceinline__ void phase_norm(const float* src_lat, const float* src_ctx, const float* g, const float* mod, int sh_off, int sc_off, int nrows, bf16_t* dst, const float* part = nullptr, float* ctx_wb = nullptr) {
    const int tid_ = otid(); const int lane = tid_ & 63, wv = tid_ >> 6;
    for (int row = blockIdx.x * 8 + wv; row < nrows; row += gridDim.x * 8) {
        const float* xr = row < RL ? src_lat + (size_t)row * DM : src_ctx + (size_t)(row - RL) * DM;
        const int bidx = row < RL ? (row >> 12) : 4;
        const float* mr = mod + (size_t)bidx * MODW;
        f32x4 v[8]; float ss = 0.f;
#pragma unroll
        for (int it = 0; it < 8; ++it) { v[it] = *(const f32x4*)(xr + (it * 64 + lane) * 4); }
        if (part != nullptr && row >= RL) {
            const float* pr = part + (size_t)(row - RL) * DM; float* wb = ctx_wb + (size_t)(row - RL) * DM;
#pragma unroll
            for (int it = 0; it < 8; ++it) { const int col = (it * 64 + lane) * 4;
                v[it] += (*(const f32x4*)(pr + col) + *(const f32x4*)(pr + (size_t)RC * DM + col)) + (*(const f32x4*)(pr + (size_t)2 * RC * DM + col) + *(const f32x4*)(pr + (size_t)3 * RC * DM + col));
                *(f32x4*)(wb + col) = v[it]; }
        }
#pragma unroll
        for (int it = 0; it < 8; ++it) ss += v[it][0] * v[it][0] + v[it][1] * v[it][1] + v[it][2] * v[it][2] + v[it][3] * v[it][3];
        f32x4 pg[8], psc[8], psh[8];
#pragma unroll
        for (int it = 0; it < 8; ++it) { const int col = (it * 64 + lane) * 4; pg[it] = *(const f32x4*)(g + col); psc[it] = *(const f32x4*)(mr + sc_off + col); psh[it] = *(const f32x4*)(mr + sh_off + col); }
        ss = wave_sum(ss);
        const float rstd = rsqrtf(ss * (1.0f / DM) + EPS);
#pragma unroll
        for (int it = 0; it < 8; ++it) {
            const int col = (it * 64 + lane) * 4;
            const f32x4 h = v[it] * rstd * pg[it] * (1.0f + psc[it]) + psh[it];
            u32x2 w; w.x = cvt_pk_bf16(h[0], h[1]); w.y = cvt_pk_bf16(h[2], h[3]);
            *(u32x2*)(dst + (size_t)row * DM + col) = w;
        }
    }
}
__device__ __forceinline__ void phase_final_norm(const float* src, const float* g, float* out) {
    const int tid_ = otid(); const int lane = tid_ & 63, wv = tid_ >> 6;
    for (int row = blockIdx.x * 8 + wv; row < RL; row += gridDim.x * 8) {
        const float* xr = src + (size_t)row * DM;
        f32x4 v[8]; float ss = 0.f;
#pragma unroll
        for (int it = 0; it < 8; ++it) { v[it] = *(const f32x4*)(xr + (it * 64 + lane) * 4); ss += v[it][0] * v[it][0] + v[it][1] * v[it][1] + v[it][2] * v[it][2] + v[it][3] * v[it][3]; }
        f32x4 pg[8];
#pragma unroll
        for (int it = 0; it < 8; ++it) pg[it] = *(const f32x4*)(g + (it * 64 + lane) * 4);
        ss = wave_sum(ss);
        const float rstd = rsqrtf(ss * (1.0f / DM) + EPS);
#pragma unroll
        for (int it = 0; it < 8; ++it) { const int col = (it * 64 + lane) * 4; *(f32x4*)(out + (size_t)row * DM + col) = v[it] * rstd * pg[it]; }
    }
}

__device__ __forceinline__ void phase_merge(const Params& p, int l, int nrows) {
    const bf16_t* Z = (const bf16_t*)(p.ws + WS_Z);
    const bf16_t* O0 = (const bf16_t*)(p.ws + WS_O);
    const bf16_t* O1 = (const bf16_t*)(p.ws + WS_O + SZ_O1);
    bf16_t* Y = (bf16_t*)(p.ws + WS_A);
    const int tid_ = otid(); const int lane = tid_ & 63, wv = tid_ >> 6;
    const f32x4 gg = *(const f32x4*)(p.gla_g_norm + l * 256 + lane * 4), gm = *(const f32x4*)(p.mlstm_g_norm + l * 256 + lane * 4);
    for (int row = blockIdx.x * 8 + wv; row < nrows; row += gridDim.x * 8) {
        u32x2 oa[8], ob[8], og[8];
#pragma unroll
        for (int hd = 0; hd < 8; ++hd) {
            const int col = hd * 256 + lane * 4;
            const int gcol = hd < 4 ? (ZC_GG + hd * 256 + lane * 4) : (ZC_MO + (hd - 4) * 256 + lane * 4);
            oa[hd] = *(const u32x2*)(O0 + (size_t)row * DM + col); ob[hd] = *(const u32x2*)(O1 + (size_t)row * DM + col); og[hd] = *(const u32x2*)(Z + (size_t)row * PWP + gcol);
        }
#pragma unroll
        for (int hd = 0; hd < 8; ++hd) {
            const int col = hd * 256 + lane * 4;
            const u32x2 a = oa[hd], b = ob[hd], gz = og[hd];
            f32x4 v; v[0] = lo_bf(a.x) + lo_bf(b.x); v[1] = hi_bf(a.x) + hi_bf(b.x); v[2] = lo_bf(a.y) + lo_bf(b.y); v[3] = hi_bf(a.y) + hi_bf(b.y);
            float ss = v[0] * v[0] + v[1] * v[1] + v[2] * v[2] + v[3] * v[3];
            ss = wave_sum(ss);
            const float rstd = rsqrtf(ss * (1.0f / 256.0f) + EPS);
            f32x4 gt; gt[0] = lo_bf(gz.x); gt[1] = hi_bf(gz.x); gt[2] = lo_bf(gz.y); gt[3] = hi_bf(gz.y);
            f32x4 y;
            if (hd < 4) { for (int e = 0; e < 4; ++e) y[e] = v[e] * rstd * gg[e] * siluf_(gt[e]); }
            else { for (int e = 0; e < 4; ++e) y[e] = sigmoidf_(gt[e]) * (v[e] * rstd * gm[e]); }
            u32x2 w; w.x = cvt_pk_bf16(y[0], y[1]); w.y = cvt_pk_bf16(y[2], y[3]);
            *(u32x2*)(Y + (size_t)row * DM + col) = w;
        }
    }
}

__device__ __forceinline__ void phase_conv(const Params& p, int l, bool with_ctx, bool dry = false) {
    bf16_t* U = (bf16_t*)(p.ws + WS_UZ);
    const float* cw = p.conv_w + (size_t)l * 9 * DFF;
    const float* cb = p.conv_b + (size_t)l * DFF;
    const int tid = otid();
    constexpr int NFG = DFF / 4;
    const int n_lat = NB * 64 * 8 * NFG, n_ctx = with_ctx ? NB * 32 * NFG : 0;
    for (int item = blockIdx.x * 512 + tid; item < n_lat + n_ctx; item += gridDim.x * 512) {
        int fg, rowbase, ncols, c0, nrowsg, r;
        if (item < n_lat) { fg = item % NFG; const int rest = item / NFG; const int seg = rest & 7; r = (rest >> 3) & 63; const int b = rest >> 9; rowbase = b * TL; ncols = 64; nrowsg = 64; c0 = seg * 8; }
        else { const int it2 = item - n_lat; fg = it2 % NFG; const int rest = it2 / NFG; const int seg = rest & 31, b = rest >> 5; rowbase = RL + b * TC; ncols = 256; nrowsg = 1; r = 0; c0 = seg * 8; }
        const int f0 = fg * 4;
        u32x2 G[3][10];
        float rowok[3];
#pragma unroll
        for (int dy = 0; dy < 3; ++dy) {
            const int rr = r + dy - 1; const bool rok = rr >= 0 && rr < nrowsg; rowok[dy] = rok ? 1.0f : 0.0f;
            const int rrc = rr < 0 ? 0 : (rr >= nrowsg ? nrowsg - 1 : rr);
#pragma unroll
            for (int j = 0; j < 10; ++j) {
                const int cc = c0 + j - 1; const int ccc = cc < 0 ? 0 : (cc >= ncols ? ncols - 1 : cc);
                G[dy][j] = *(const u32x2*)(U + (size_t)(rowbase + rrc * ncols + ccc) * DFF2 + f0);
            }
        }
        const bool lok = c0 > 0, rok9 = c0 + 8 < ncols;
#pragma unroll
        for (int dy = 0; dy < 3; ++dy) { if (!lok) G[dy][0] = (u32x2){0u, 0u}; if (!rok9) G[dy][9] = (u32x2){0u, 0u}; }
        u32x2 V[8];
        bf16_t* vp = U + (size_t)(rowbase + r * ncols + c0) * DFF2 + DFF + f0;
#pragma unroll
        for (int t = 0; t < 8; ++t) V[t] = *(const u32x2*)(vp + (size_t)t * DFF2);
        typedef float f32x2 __attribute__((ext_vector_type(2)));
        f32x2 W01[3][3], W23[3][3];
#pragma unroll
        for (int dy = 0; dy < 3; ++dy)
#pragma unroll
            for (int dx = 0; dx < 3; ++dx) { const f32x4 w = *(const f32x4*)(cw + (size_t)(dy * 3 + dx) * DFF + f0) * rowok[dy]; W01[dy][dx] = (f32x2){w[0], w[1]}; W23[dy][dx] = (f32x2){w[2], w[3]}; }
        const f32x4 bias = *(const f32x4*)(cb + f0);
        f32x2 P01[3][10], P23[3][10];
#pragma unroll
        for (int dy = 0; dy < 3; ++dy)
#pragma unroll
            for (int j = 0; j < 10; ++j) { const u32x2 g = G[dy][j];
                P01[dy][j] = (f32x2){lo_bf(g.x), hi_bf(g.x)}; P23[dy][j] = (f32x2){lo_bf(g.y), hi_bf(g.y)}; }
#pragma unroll
        for (int t = 0; t < 8; ++t) {
            f32x2 a01 = (f32x2){bias[0], bias[1]}, a23 = (f32x2){bias[2], bias[3]};
#pragma unroll
            for (int dy = 0; dy < 3; ++dy)
#pragma unroll
                for (int dx = 0; dx < 3; ++dx) { a01 = P01[dy][t + dx] * W01[dy][dx] + a01; a23 = P23[dy][t + dx] * W23[dy][dx] + a23; }
            u32x2 o;
            o.x = cvt_pk_bf16(siluf_(a01[0]) * lo_bf(V[t].x), siluf_(a01[1]) * hi_bf(V[t].x));
            o.y = cvt_pk_bf16(siluf_(a23[0]) * lo_bf(V[t].y), siluf_(a23[1]) * hi_bf(V[t].y));
            if (!dry || o.x == 0x7fc17fc1u) *(u32x2*)(vp + (size_t)t * DFF2) = o;
        }
    }
}

constexpr int NCHUNK = RT / 64;
__device__ __forceinline__ void phase_decay(const Params& p, int l, LAS unsigned char* lds) {
    LAS float* W = (LAS float*)lds;
    LAS float* Bv = (LAS float*)(lds + 65536);
    const int tid = otid(), lane = tid & 63, wv = tid >> 6;
    __syncthreads();
    {
        f32x4 wv4[8];
        const f32x4* wsrc = (const f32x4*)(p.gla_w_lr + (size_t)l * 2 * 16 * 512);
#pragma unroll
        for (int q = 0; q < 8; ++q) wv4[q] = wsrc[q * 512 + tid];
        float bvv[2];
#pragma unroll
        for (int q = 0; q < 2; ++q) bvv[q] = p.gla_b_lr[(size_t)l * 2 * 512 + q * 512 + tid];
#pragma unroll
        for (int q = 0; q < 8; ++q) ((LAS f32x4*)W)[q * 512 + tid] = wv4[q];
#pragma unroll
        for (int q = 0; q < 2; ++q) Bv[q * 512 + tid] = bvv[q];
    }
    __syncthreads();
    const bf16_t* Z = (const bf16_t*)(p.ws + WS_Z);
    bf16_t* QAg = (bf16_t*)(p.ws + WS_A);
    bf16_t* KAg = QAg + (size_t)2 * RT * 512;
    float* EEND = (float*)(p.ws + WS_EEND);
    const float qk_scale = 0.08838834764831845f;
    bf16_t* MQg = (bf16_t*)(p.ws + WS_MQK);
    bf16_t* MKg = MQg + (size_t)RT * 512;
    float* GATES = (float*)(p.ws + WS_GATES);
    u32x4 pf[6]; bool pf_valid = false;
#pragma unroll
    for (int q = 0; q < 6; ++q) pf[q] = (u32x4){0u, 0u, 0u, 0u};
    for (int item = blockIdx.x * 8 + wv; item < NCHUNK * 2 * 32 + NCHUNK * 32; item += gridDim.x * 8) {
        if (item >= NCHUNK * 2 * 32) {
            const int it2 = item - NCHUNK * 2 * 32, cg = it2 & 31, chunk = it2 >> 5;
            const int row = chunk * 64 + lane;
            const bf16_t* zr = Z + (size_t)row * PWP;
            const u32x4 q0 = *(const u32x4*)(zr + ZC_MQ + cg * 16), q1 = *(const u32x4*)(zr + ZC_MQ + cg * 16 + 8);
            const u32x4 k0 = *(const u32x4*)(zr + ZC_MK + cg * 16), k1 = *(const u32x4*)(zr + ZC_MK + cg * 16 + 8);
            const unsigned kw[8] = {k0.x, k0.y, k0.z, k0.w, k1.x, k1.y, k1.z, k1.w};
            unsigned ks[8];
#pragma unroll
            for (int e = 0; e < 8; ++e) ks[e] = cvt_pk_bf16(lo_bf(kw[e]) * qk_scale, hi_bf(kw[e]) * qk_scale);
            u32x4* qd = (u32x4*)(MQg + ((size_t)chunk * 32 + cg) * 1024 + lane * 16);
            u32x4* kd = (u32x4*)(MKg + ((size_t)chunk * 32 + cg) * 1024 + lane * 16);
            qd[0] = q0; qd[1] = q1;
            kd[0] = (u32x4){ks[0], ks[1], ks[2], ks[3]}; kd[1] = (u32x4){ks[4], ks[5], ks[6], ks[7]};
            if ((cg & 7) == 0) {
                const int h = cg >> 3;
#pragma unroll
                for (int dir = 0; dir < 2; ++dir) {
                    const float bi = p.mlstm_b_gate[((l * 2 + dir) * 2 + 0) * 4 + h], bf = p.mlstm_b_gate[((l * 2 + dir) * 2 + 1) * 4 + h];
                    const int rowd = chunk * 64 + (dir ? 63 - lane : lane);
                    const bf16_t* zd = Z + (size_t)rowd * PWP;
                    const float logi = bf2f(zd[ZC_MG + dir * 8 + h]) + bi;
                    const float logf = logsigf_(bf2f(zd[ZC_MG + dir * 8 + 4 + h]) + bf);
                    const float fcum = wave_incl_sum(logf), av = logi - fcum, aj = wave_incl_max(av);
                    GATES[(size_t)((dir * 4 + h) * 3 + 0) * RT + rowd] = fcum;
                    GATES[(size_t)((dir * 4 + h) * 3 + 1) * RT + rowd] = av;
                    GATES[(size_t)((dir * 4 + h) * 3 + 2) * RT + rowd] = aj;
                }
            }
            continue;
        }
        const int cg = item & 31, dir = (item >> 5) & 1, chunk = item >> 6;
        if (!pf_valid) { const int row = chunk * 64 + (dir ? 63 - lane : lane); const bf16_t* zr = Z + (size_t)row * PWP;
            pf[0] = *(const u32x4*)(zr + ZC_LR); pf[1] = *(const u32x4*)(zr + ZC_LR + 8); pf[2] = *(const u32x4*)(zr + ZC_GQ + cg * 16); pf[3] = *(const u32x4*)(zr + ZC_GQ + cg * 16 + 8);
            pf[4] = *(const u32x4*)(zr + ZC_GK + cg * 16); pf[5] = *(const u32x4*)(zr + ZC_GK + cg * 16 + 8); }
        const u32x4 g0 = pf[0], g1 = pf[1], q0 = pf[2], q1 = pf[3], k0 = pf[4], k1 = pf[5];
        {
            const int nitem = item + (int)gridDim.x * 8;
            pf_valid = nitem < NCHUNK * 2 * 32;
            if (pf_valid) { const int ncg = nitem & 31, ndir = (nitem >> 5) & 1, nchunk = nitem >> 6; const int nrow = nchunk * 64 + (ndir ? 63 - lane : lane); const bf16_t* zn = Z + (size_t)nrow * PWP;
                pf[0] = *(const u32x4*)(zn + ZC_LR); pf[1] = *(const u32x4*)(zn + ZC_LR + 8); pf[2] = *(const u32x4*)(zn + ZC_GQ + ncg * 16); pf[3] = *(const u32x4*)(zn + ZC_GQ + ncg * 16 + 8);
                pf[4] = *(const u32x4*)(zn + ZC_GK + ncg * 16); pf[5] = *(const u32x4*)(zn + ZC_GK + ncg * 16 + 8); }
        }
        const unsigned gw[8] = {g0.x, g0.y, g0.z, g0.w, g1.x, g1.y, g1.z, g1.w};
        const unsigned qw[8] = {q0.x, q0.y, q0.z, q0.w, q1.x, q1.y, q1.z, q1.w};
        const unsigned kw[8] = {k0.x, k0.y, k0.z, k0.w, k1.x, k1.y, k1.z, k1.w};
        float gl[16];
#pragma unroll
        for (int e = 0; e < 8; ++e) { gl[2 * e] = lo_bf(gw[e]); gl[2 * e + 1] = hi_bf(gw[e]); }
        unsigned qaw[8], kaw[8]; float eesel = 0.f;
#pragma unroll
        for (int c4 = 0; c4 < 4; ++c4) {
            const int ch0 = cg * 16 + c4 * 4;
            f32x4 dec = *(const LAS f32x4*)(Bv + dir * 512 + ch0);
#pragma unroll
            for (int r = 0; r < 16; ++r) dec += gl[r] * *(const LAS f32x4*)(W + (dir * 16 + r) * 512 + ch0);
            float qa[4], ka[4], la4[4];
#pragma unroll
            for (int e = 0; e < 4; ++e) la4[e] = logsigf_(dec[e]) * (1.0f / 16.0f);
#pragma unroll
            for (int e = 0; e < 4; ++e) la4[e] += dpp_f<0x111, 0xF>(la4[e], 0.f);
#pragma unroll
            for (int e = 0; e < 4; ++e) la4[e] += dpp_f<0x112, 0xF>(la4[e], 0.f);
#pragma unroll
            for (int e = 0; e < 4; ++e) la4[e] += dpp_f<0x114, 0xF>(la4[e], 0.f);
#pragma unroll
            for (int e = 0; e < 4; ++e) la4[e] += dpp_f<0x118, 0xF>(la4[e], 0.f);
#pragma unroll
            for (int e = 0; e < 4; ++e) la4[e] += dpp_f<0x142, 0xA>(la4[e], 0.f);
#pragma unroll
            for (int e = 0; e < 4; ++e) la4[e] += dpp_f<0x143, 0xC>(la4[e], 0.f);
#pragma unroll
            for (int e = 0; e < 4; ++e) {
                const int cc = c4 * 4 + e;
                const float la = la4[e];
                const float ev = __expf(la), eend = rdlane63(ev), rc = __builtin_amdgcn_rcpf(ev);
                const float qv = (cc & 1) ? hi_bf(qw[cc >> 1]) : lo_bf(qw[cc >> 1]);
                const float kv = (cc & 1) ? hi_bf(kw[cc >> 1]) : lo_bf(kw[cc >> 1]);
                qa[e] = qv * ev * qk_scale; ka[e] = kv * rc;
                eesel = (lane == cc) ? eend : eesel;
            }
            qaw[c4 * 2] = cvt_pk_bf16(qa[0], qa[1]); qaw[c4 * 2 + 1] = cvt_pk_bf16(qa[2], qa[3]);
            kaw[c4 * 2] = cvt_pk_bf16(ka[0], ka[1]); kaw[c4 * 2 + 1] = cvt_pk_bf16(ka[2], ka[3]);
        }
        u32x4* qd = (u32x4*)(QAg + (((size_t)dir * NCHUNK + chunk) * 32 + cg) * 1024 + lane * 16);
        u32x4* kd = (u32x4*)(KAg + (((size_t)dir * NCHUNK + chunk) * 32 + cg) * 1024 + lane * 16);
        qd[0] = (u32x4){qaw[0], qaw[1], qaw[2], qaw[3]}; qd[1] = (u32x4){qaw[4], qaw[5], qaw[6], qaw[7]};
        kd[0] = (u32x4){kaw[0], kaw[1], kaw[2], kaw[3]}; kd[1] = (u32x4){kaw[4], kaw[5], kaw[6], kaw[7]};
        if (lane < 16) EEND[((size_t)dir * NCHUNK + chunk) * 512 + cg * 16 + lane] = eesel;
    }
}

constexpr int SC_QA = 0, SC_KA = 17408, SC_KE = 34816, SC_VT = 53248  , SC_PP = 71680  , SC_ST = 90112, SC_AV = 108064, SC_MJ = 108320, SC_INTER = 108576, SC_MQ = 108832, SC_END = 109088;
constexpr int SC_VTB = 9216, SC_PPB = 9216;
constexpr int LD_QK = 136, LD_T = 72;
static_assert(SC_END <= LDS_BYTES, "scan lds");

__device__ __forceinline__ bf16x8 lds_frag(const LAS unsigned char* base, int row, int ld_elems, int kk, int fq) {
    return *(const LAS bf16x8*)(base + (size_t)(row * ld_elems + fq * 8 + kk * 32) * 2);
}
struct ScanIn { u32x4 q0, q1, k0, k1, vv; f32x4 ee; float gi, gf, ga; };

template <int grp>
__device__ __forceinline__ void scan_item(const Params& p, const int l, LAS unsigned char* lds, const int dir, const int dvq, const int h, const int b) {
    const bf16_t* Z = (const bf16_t*)(p.ws + WS_Z);
    const bf16_t* QAg = (const bf16_t*)(p.ws + WS_A);
    const bf16_t* KAg = QAg + (size_t)2 * RT * 512;
    const float* EEND = (const float*)(p.ws + WS_EEND);
    const bf16_t* MQg = (const bf16_t*)(p.ws + WS_MQK);
    const bf16_t* MKg = MQg + (size_t)RT * 512;
    const float* GATES = (const float*)(p.ws + WS_GATES);
    bf16_t* Obuf = (bf16_t*)(p.ws + WS_O);
    int tid = threadIdx.x; asm volatile("" : "+v"(tid));
    const int lane = tid & 63, wv = __builtin_amdgcn_readfirstlane(tid >> 6), fr = lane & 15, fq = lane >> 4;
    LAS bf16_t* QA = (LAS bf16_t*)(lds + SC_QA); LAS bf16_t* KA = (LAS bf16_t*)(lds + SC_KA); LAS bf16_t* KE = (LAS bf16_t*)(lds + SC_KE);
    LAS bf16_t* VT = (LAS bf16_t*)(lds + SC_VT); LAS bf16_t* PP = (LAS bf16_t*)(lds + SC_PP); LAS bf16_t* ST = (LAS bf16_t*)(lds + SC_ST);
    LAS float* AV = (LAS float*)(lds + SC_AV); LAS float* MJ = (LAS float*)(lds + SC_MJ); LAS float* INTER = (LAS float*)(lds + SC_INTER); LAS float* MQ = (LAS float*)(lds + SC_MQ);
    const LAS unsigned char* QAb = (const LAS unsigned char*)QA; const LAS unsigned char* KAb = (const LAS unsigned char*)KA; const LAS unsigned char* KEb = (const LAS unsigned char*)KE;
    const LAS unsigned char* VTb = (const LAS unsigned char*)VT; const LAS unsigned char* PPb = (const LAS unsigned char*)PP; const LAS unsigned char* STb = (const LAS unsigned char*)ST;
    const float qk_scale = 0.08838834764831845f;
    const short one_or_zero = (fr == 0) ? (short)0x3F80 : (short)0;
    const bf16x8 ones_frag = {one_or_zero, one_or_zero, one_or_zero, one_or_zero, one_or_zero, one_or_zero, one_or_zero, one_or_zero};
    const bf16x8 zero_frag = {0, 0, 0, 0, 0, 0, 0, 0};

        __syncthreads();
        for (int i = tid; i < 66 * LD_QK / 2; i += 512) ((LAS unsigned*)ST)[i] = 0u;
        float bg_i = 0.f, bg_f = 0.f;
        if (grp == 1) { bg_i = p.mlstm_b_gate[((l * 2 + dir) * 2 + 0) * 4 + h]; bg_f = p.mlstm_b_gate[((l * 2 + dir) * 2 + 1) * 4 + h]; }
        f32x4 S[4], S5 = {0.f, 0.f, 0.f, 0.f};
#pragma unroll
        for (int q4 = 0; q4 < 4; ++q4) S[q4] = (f32x4){0.f, 0.f, 0.f, 0.f};
        float m_run = 0.f;
        const int qcol = ZC_MQ + h * 128 + wv * 16, kcol = ZC_MK + h * 128 + wv * 16;
        const int gqcol = h * 128 + wv * 16;
        const int vcol = (grp == 0 ? ZC_GV : ZC_MV) + h * 256 + dvq * 64 + wv * 8;
        const int ocol = grp * 1024 + h * 256 + dvq * 64;
        const int gcol_i = ZC_MG + dir * 8 + h, gcol_f = ZC_MG + dir * 8 + 4 + h;
        __syncthreads();

        auto load_step = [&](int s) -> ScanIn {
            ScanIn in;
            const bool is_ctx = s < 4;
            const int cch = is_ctx ? s : s - 4;
            const int nch = is_ctx ? (TC / 64) : (TL / 64);
            const int rowbase = is_ctx ? (RL + b * TC) : (b * TL);
            const int mc = dir ? (nch - 1 - cch) : cch;
            const int row = rowbase + mc * 64 + (dir ? 63 - lane : lane);
            const bf16_t* zr = Z + (size_t)row * PWP;
            in.vv = *(const u32x4*)(zr + vcol);
            in.gi = GATES[(size_t)((dir * 4 + h) * 3 + 0) * RT + row]; in.gf = GATES[(size_t)((dir * 4 + h) * 3 + 1) * RT + row]; in.ga = GATES[(size_t)((dir * 4 + h) * 3 + 2) * RT + row];
            const int gchunk = (rowbase >> 6) + mc;
            if (grp == 0) {
                const bf16_t* qr = QAg + (((size_t)dir * NCHUNK + gchunk) * 32 + h * 8 + wv) * 1024 + lane * 16;
                const bf16_t* kr = KAg + (((size_t)dir * NCHUNK + gchunk) * 32 + h * 8 + wv) * 1024 + lane * 16;
                in.q0 = *(const u32x4*)(qr); in.q1 = *(const u32x4*)(qr + 8);
                in.k0 = *(const u32x4*)(kr); in.k1 = *(const u32x4*)(kr + 8);
                in.ee = *(const f32x4*)(EEND + ((size_t)dir * NCHUNK + gchunk) * 512 + gqcol + fq * 4);
            } else {
                const int tm = dir ? 63 - lane : lane;
                const bf16_t* qr = MQg + ((size_t)gchunk * 32 + h * 8 + wv) * 1024 + tm * 16;
                const bf16_t* kr = MKg + ((size_t)gchunk * 32 + h * 8 + wv) * 1024 + tm * 16;
                in.q0 = *(const u32x4*)(qr); in.q1 = *(const u32x4*)(qr + 8);
                in.k0 = *(const u32x4*)(kr); in.k1 = *(const u32x4*)(kr + 8);
                in.ee = (f32x4){1.f, 1.f, 1.f, 1.f};
            }
            return in;
        };

        ScanIn cur = load_step(0);
        for (int s = 0; s < 68; ++s) {
            const bool is_ctx = s < 4;
            const int cch = is_ctx ? s : s - 4;
            const int nch = is_ctx ? (TC / 64) : (TL / 64);
            const int rowbase = is_ctx ? (RL + b * TC) : (b * TL);
            const int mc = dir ? (nch - 1 - cch) : cch;
            const bool want_out = (!is_ctx) || (l == 0);
            const int par = s & 1;
            LAS bf16_t* VTp = VT + par * (SC_VTB / 2); LAS bf16_t* PPp = PP + par * (SC_PPB / 2);
            const LAS unsigned char* VTpb = VTb + par * SC_VTB; const LAS unsigned char* PPpb = PPb + par * SC_PPB;
            const unsigned qw[8] = {cur.q0.x, cur.q0.y, cur.q0.z, cur.q0.w, cur.q1.x, cur.q1.y, cur.q1.z, cur.q1.w};
            const unsigned kw[8] = {cur.k0.x, cur.k0.y, cur.k0.z, cur.k0.w, cur.k1.x, cur.k1.y, cur.k1.z, cur.k1.w};
            float m_new = 0.f, cs = 1.f;
            unsigned kaw[8];
            if (grp == 0) {
#pragma unroll
                for (int e = 0; e < 8; ++e) {
                    const int ch = wv * 16 + 2 * e;
                    kaw[e] = kw[e];
                    KE[ch * LD_T + lane] = (bf16_t)(kw[e] & 0xffffu);
                    KE[(ch + 1) * LD_T + lane] = (bf16_t)(kw[e] >> 16);
                }
            } else {
                const float fcum = cur.gi, av = cur.gf, Aj = cur.ga;
                const float fend = rdlane63(fcum);
                const float amax = rdlane63(Aj);
                m_new = fmaxf(fend + m_run, fend + amax);
                cs = __expf(fend + m_run - m_new);
                const float wi = __expf(fend + av - m_new);
                const float Mj = fmaxf(m_run, Aj);
                if (wv == 0) { AV[lane] = av; MJ[lane] = Mj; INTER[lane] = __expf(m_run - Mj); MQ[lane] = fcum + Mj; }
#pragma unroll
                for (int e = 0; e < 8; ++e) {
                    const float k_lo = lo_bf(kw[e]), k_hi = hi_bf(kw[e]);
                    const int ch = wv * 16 + 2 * e;
                    kaw[e] = kw[e];
                    const unsigned ke = cvt_pk_bf16(wi * k_lo, wi * k_hi);
                    KE[ch * LD_T + lane] = (bf16_t)(ke & 0xffffu);
                    KE[(ch + 1) * LD_T + lane] = (bf16_t)(ke >> 16);
                }
            }
            { LAS u32x4* qd = (LAS u32x4*)(QA + lane * LD_QK + wv * 16); qd[0] = cur.q0; qd[1] = cur.q1;
              LAS u32x4* kd = (LAS u32x4*)(KA + lane * LD_QK + wv * 16); kd[0] = (u32x4){kaw[0], kaw[1], kaw[2], kaw[3]}; kd[1] = (u32x4){kaw[4], kaw[5], kaw[6], kaw[7]}; }
            { const unsigned vw[4] = {cur.vv.x, cur.vv.y, cur.vv.z, cur.vv.w};
#pragma unroll
              for (int e = 0; e < 4; ++e) { VTp[(wv * 8 + 2 * e) * LD_T + lane] = (bf16_t)(vw[e] & 0xffffu); VTp[(wv * 8 + 2 * e + 1) * LD_T + lane] = (bf16_t)(vw[e] >> 16); } }
            f32x4 ee_now = cur.ee;
            asm volatile("" : "+v"(ee_now));
            __syncthreads();
            __builtin_amdgcn_s_waitcnt(0x0F70);
            ScanIn nxt = load_step(s + 1 < 68 ? s + 1 : s);
            const int tj_o = wv & 3, j_o = tj_o * 16 + fr;
            f32x4 a2[2] = {{0.f, 0.f, 0.f, 0.f}, {0.f, 0.f, 0.f, 0.f}}, d2 = {0.f, 0.f, 0.f, 0.f};
            float rs = 1.f, emq = 0.f;
            const bf16x8 ak0 = lds_frag(KEb, wv * 16 + fr, LD_T, 0, fq), ak1 = lds_frag(KEb, wv * 16 + fr, LD_T, 1, fq);
            if (want_out) {
                const int t0 = wv * 2, tja = t0 >> 2, ti0 = t0 & 3, ti1 = ti0 + 1;
                const bool on0 = ti0 <= tja, on1 = ti1 <= tja;
                bf16x8 fq_[4], fk0[4], fk1[4];
#pragma unroll
                for (int kk = 0; kk < 4; ++kk) { fq_[kk] = lds_frag(QAb, tja * 16 + fr, LD_QK, kk, fq); fk0[kk] = lds_frag(KAb, ti0 * 16 + fr, LD_QK, kk, fq); fk1[kk] = lds_frag(KAb, ti1 * 16 + fr, LD_QK, kk, fq); }
                bf16x8 bq[4], fs0[4], fs1[4];
                const int tv0 = (wv >> 2) * 2;
#pragma unroll
                for (int kk = 0; kk < 4; ++kk) { bq[kk] = lds_frag(QAb, j_o, LD_QK, kk, fq); fs0[kk] = lds_frag(STb, tv0 * 16 + fr, LD_QK, kk, fq); fs1[kk] = lds_frag(STb, (tv0 + 1) * 16 + fr, LD_QK, kk, fq); }
                __builtin_amdgcn_sched_barrier(0);
                f32x4 acc0 = {0.f, 0.f, 0.f, 0.f}, acc1 = {0.f, 0.f, 0.f, 0.f};
                if (on0) {
#pragma unroll
                    for (int kk = 0; kk < 4; ++kk) acc0 = __builtin_amdgcn_mfma_f32_16x16x32_bf16(fk0[kk], fq_[kk], acc0, 0, 0, 0);
                }
                if (on1) {
#pragma unroll
                    for (int kk = 0; kk < 4; ++kk) acc1 = __builtin_amdgcn_mfma_f32_16x16x32_bf16(fk1[kk], fq_[kk], acc1, 0, 0, 0);
                }
                {
                    f32x4 a = {0.f, 0.f, 0.f, 0.f}, b = {0.f, 0.f, 0.f, 0.f};
#pragma unroll
                    for (int kk = 0; kk < 4; ++kk) { a = __builtin_amdgcn_mfma_f32_16x16x32_bf16(fs0[kk], bq[kk], a, 0, 0, 0); b = __builtin_amdgcn_mfma_f32_16x16x32_bf16(fs1[kk], bq[kk], b, 0, 0, 0); }
                    a2[0] = a; a2[1] = b;
                }
                if (grp == 1) {
                    bf16x8 n0 = lds_frag(STb, 64, LD_QK, 0, fq), n1 = lds_frag(STb, 64, LD_QK, 1, fq), n2 = lds_frag(STb, 64, LD_QK, 2, fq), n3 = lds_frag(STb, 64, LD_QK, 3, fq);
                    if (fr != 0) { n0 = zero_frag; n1 = zero_frag; n2 = zero_frag; n3 = zero_frag; }
                    d2 = __builtin_amdgcn_mfma_f32_16x16x32_bf16(n0, bq[0], d2, 0, 0, 0);
                    d2 = __builtin_amdgcn_mfma_f32_16x16x32_bf16(n1, bq[1], d2, 0, 0, 0);
                    d2 = __builtin_amdgcn_mfma_f32_16x16x32_bf16(n2, bq[2], d2, 0, 0, 0);
                    d2 = __builtin_amdgcn_mfma_f32_16x16x32_bf16(n3, bq[3], d2, 0, 0, 0);
                    rs = INTER[j_o]; emq = __expf(-MQ[j_o]);
                }
                {
                    const int j = tja * 16 + fr;
#pragma unroll
                    for (int tt = 0; tt < 2; ++tt) {
                        const int i0 = (ti0 + tt) * 16 + fq * 4; const f32x4 acc = tt ? acc1 : acc0;
                        float vals[4];
                        if (grp == 1) {
                            const f32x4 av4 = *(const LAS f32x4*)(AV + i0); const float mj = MJ[j];
#pragma unroll
                            for (int r = 0; r < 4; ++r) vals[r] = (i0 + r <= j) ? acc[r] * __expf(av4[r] - mj) : 0.f;
                        } else {
#pragma unroll
                            for (int r = 0; r < 4; ++r) vals[r] = (i0 + r <= j) ? acc[r] : 0.f;
                        }
                        u32x2 w; w.x = cvt_pk_bf16(vals[0], vals[1]); w.y = cvt_pk_bf16(vals[2], vals[3]);
                        *(LAS u32x2*)(PPp + j * LD_T + i0) = w;
                    }
                }
            }
            {
                bf16x8 fv[4][2];
#pragma unroll
                for (int tv = 0; tv < 4; ++tv) { fv[tv][0] = lds_frag(VTpb, tv * 16 + fr, LD_T, 0, fq); fv[tv][1] = lds_frag(VTpb, tv * 16 + fr, LD_T, 1, fq); }
                __builtin_amdgcn_sched_barrier(0);
#pragma unroll
                for (int tv = 0; tv < 4; ++tv) {
                    f32x4 a = S[tv] * cs;
                    a = __builtin_amdgcn_mfma_f32_16x16x32_bf16(ak0, fv[tv][0], a, 0, 0, 0);
                    a = __builtin_amdgcn_mfma_f32_16x16x32_bf16(ak1, fv[tv][1], a, 0, 0, 0);
                    S[tv] = a * ee_now;
                }
                if (grp == 1) {
                    f32x4 a = S5 * cs;
                    a = __builtin_amdgcn_mfma_f32_16x16x32_bf16(ak0, ones_frag, a, 0, 0, 0);
                    a = __builtin_amdgcn_mfma_f32_16x16x32_bf16(ak1, ones_frag, a, 0, 0, 0);
                    S5 = a;
                }
            }
            __syncthreads();
            {
#pragma unroll
                for (int tv = 0; tv < 4; ++tv) { u32x2 w; w.x = cvt_pk_bf16(S[tv][0], S[tv][1]); w.y = cvt_pk_bf16(S[tv][2], S[tv][3]);
                    *(LAS u32x2*)(ST + (tv * 16 + fr) * LD_QK + wv * 16 + fq * 4) = w; }
                if (grp == 1 && fr == 0) { u32x2 w; w.x = cvt_pk_bf16(S5[0], S5[1]); w.y = cvt_pk_bf16(S5[2], S5[3]);
                    *(LAS u32x2*)(ST + 64 * LD_QK + wv * 16 + fq * 4) = w; }
            }
            if (want_out) {
                const bf16x8 bp0 = lds_frag(PPpb, j_o, LD_T, 0, fq), bp1 = lds_frag(PPpb, j_o, LD_T, 1, fq);
                bf16x8 fvb[2][2];
#pragma unroll
                for (int tt = 0; tt < 2; ++tt) { const int tv = (wv >> 2) * 2 + tt; fvb[tt][0] = lds_frag(VTpb, tv * 16 + fr, LD_T, 0, fq); fvb[tt][1] = lds_frag(VTpb, tv * 16 + fr, LD_T, 1, fq); }
                __builtin_amdgcn_sched_barrier(0);
                float dn = 1.f;
                if (grp == 1) {
                    f32x4 d1 = {0.f, 0.f, 0.f, 0.f};
                    d1 = __builtin_amdgcn_mfma_f32_16x16x32_bf16(ones_frag, bp0, d1, 0, 0, 0);
                    d1 = __builtin_amdgcn_mfma_f32_16x16x32_bf16(ones_frag, bp1, d1, 0, 0, 0);
                    float den = d1[0] + rs * d2[0];
                    den = __int_as_float(__builtin_amdgcn_ds_bpermute(fr << 2, __float_as_int(den)));
                    dn = __builtin_amdgcn_rcpf(fmaxf(fabsf(den), emq));
                }
                const int rowj = rowbase + mc * 64 + (dir ? 63 - j_o : j_o);
#pragma unroll
                for (int tt = 0; tt < 2; ++tt) {
                    const int tv = (wv >> 2) * 2 + tt;
                    f32x4 a1 = {0.f, 0.f, 0.f, 0.f};
                    a1 = __builtin_amdgcn_mfma_f32_16x16x32_bf16(fvb[tt][0], bp0, a1, 0, 0, 0);
                    a1 = __builtin_amdgcn_mfma_f32_16x16x32_bf16(fvb[tt][1], bp1, a1, 0, 0, 0);
                    const f32x4 o = (a1 + rs * a2[tt]) * dn;
                    u32x2 w; w.x = cvt_pk_bf16(o[0], o[1]); w.y = cvt_pk_bf16(o[2], o[3]);
                    *(u32x2*)(Obuf + (size_t)dir * RT * DM + (size_t)rowj * DM + ocol + tv * 16 + fq * 4) = w;
                }
            }
            m_run = m_new;
            cur = nxt;
        }
}

__device__ __forceinline__ void phase_scan(const Params& p, int l, LAS unsigned char* lds) {
    for (int item = blockIdx.x; item < 256; item += gridDim.x) {
        const int grp = item & 1, dir = (item >> 1) & 1, dvq = (item >> 2) & 3, h = (item >> 4) & 3, b = (item >> 6) & 3;
        if (grp == 0) scan_item<0>(p, l, lds, dir, dvq, h, b); else scan_item<1>(p, l, lds, dir, dvq, h, b);
    }
}

__global__ void __launch_bounds__(512, 2) mk_fwd(Params p) {
    extern __shared__ __attribute__((aligned(16))) unsigned char lds_raw[];
    LAS unsigned char* lds = (LAS unsigned char*)lds_raw;
    float* XB = (float*)(p.ws + WS_X);
    bf16_t* AB = (bf16_t*)(p.ws + WS_A);
    const float* MOD = (const float*)(p.ws + WS_MOD);
    int ph = 0;
    const int lo = (int)p.ph_lo, hi = (int)p.ph_hi;
#if !MULTI_LAUNCH
    if (lo < 0) cg::this_grid().sync();
    if (threadIdx.x < 4) ((LAS unsigned*)(lds + pg8::STAGE_BYTES))[threadIdx.x] = 0u;
    __syncthreads();
    const XcdBarrier gbar = xcd_barrier_post((unsigned*)(p.ws + WS_BAR), (volatile LAS unsigned*)(lds + pg8::STAGE_BYTES));
#endif
#define PHASE_BEGIN if (ph >= lo && ph < hi) {
#if MULTI_LAUNCH
#define PHASE_END } ++ph;
#else
#define PHASE_END } ++ph; if (ph > lo && ph < hi) xcd_barrier(gbar);
#endif
    PHASE_BEGIN
        for (int rep = 0; rep < REP_MISC; ++rep) { phase_mod(p, lds);
        __syncthreads(); }
        phase_wconv(p, 0, lds, 0, WC_T_IN, 0);
        phase_wconv(p, 0, lds, WC_T_IN + WC_TAIL0, WC_TOT, 0);
    PHASE_END
    for (int l = 0; l < NLAYER; ++l) {
        const float* modl = MOD + (size_t)l * 5 * MODW;
        const float* xl = l == 0 ? p.x : XB;
        const float* xc = l == 0 ? p.ctx : XB + (size_t)RL * DM;
        const int Mrows = l == 0 ? RT : RL;
        PHASE_BEGIN
            phase_norm(xl, xc, p.g_norm1 + l * DM, modl, 0, DM, RT, AB, l > 0 ? (const float*)(p.ws + WS_PART) : nullptr, XB + (size_t)RL * DM);
        PHASE_END
        PHASE_BEGIN
            pg8::Gemm g{AB, (const bf16_t*)(p.ws + WS_WIN), RT, PWP, DM, DM};
            pg8::StaticOrder S; S.init(RT, PWP, gridDim.x, blockIdx.x, DM);
            pg8::EpiBf16 E{(bf16_t*)(p.ws + WS_Z), PWP};
            for (int rep = 0; rep < REP_GEMM; ++rep) pg8::gemm_phase(lds, g, S, E);
            {
                const int nwg = (RT / 256) * (PWP / 256), extra = nwg % (int)gridDim.x;
                __syncthreads();
                if (l == 0) phase_wconv(p, 0, lds, WC_T_IN, WC_T_IN + WC_TAIL0, extra);
                else phase_wconv(p, l, lds, WC_NODN, WC_TOT, extra);
            }
        PHASE_END
        PHASE_BEGIN
#ifdef PROBE_CONV
            phase_decay(p, l, lds);
#endif
            phase_decay(p, l, lds);
        PHASE_END
        PHASE_BEGIN
            for (int rep = 0; rep < REP_SCAN; ++rep) phase_scan(p, l, lds);
        PHASE_END
        PHASE_BEGIN
            phase_merge(p, l, Mrows);
            if (l == 0) {
                const f32x4* src = (const f32x4*)p.ctx; f32x4* dst = (f32x4*)(XB + (size_t)RL * DM);
                for (int i = blockIdx.x * 512 + otid(); i < RC * DM / 4; i += gridDim.x * 512) dst[i] = src[i];
            }
        PHASE_END
        PHASE_BEGIN
            pg8::Gemm g{AB, (const bf16_t*)(p.ws + WS_WOUT), Mrows, DM, DM, DM};
            pg8::SplitTailOrder S; S.init(DM, gridDim.x, blockIdx.x, DM, l == 0);
            pg8::EpiRes E{xl, xc, XB, modl, 2 * DM, 1.0f, DM / 64, (float*)(p.ws + WS_PART)};
#ifdef PROBE_RES
            { pg8::EpiRes E0{xl, xc, XB, modl, 2 * DM, 0.0f, DM / 64, (float*)(p.ws + WS_PART)}; pg8::gemm_phase(lds, g, S, E0); }
#endif
            pg8::gemm_phase(lds, g, S, E);
        PHASE_END
        PHASE_BEGIN
            phase_norm(XB, XB + (size_t)RL * DM, p.g_norm2 + l * DM, modl, 3 * DM, 4 * DM, Mrows, AB, l == 0 ? (const float*)(p.ws + WS_PART) : nullptr, XB + (size_t)RL * DM);
        PHASE_END
        PHASE_BEGIN
            pg8::Gemm g{AB, (const bf16_t*)(p.ws + WS_WUP), Mrows, DFF2, DM, DM};
            pg8::StaticOrder S; S.init(Mrows, DFF2, gridDim.x, blockIdx.x, DM);
            pg8::EpiBf16 E{(bf16_t*)(p.ws + WS_UZ), DFF2};
            for (int rep = 0; rep < REP_GEMM; ++rep) pg8::gemm_phase(lds, g, S, E);
            if (l + 1 < NLAYER) {
                const int nwg = (Mrows / 256) * (DFF2 / 256), extra = nwg % (int)gridDim.x;
                __syncthreads();
                if (extra > 0) phase_wconv(p, l + 1, lds, 0, WC_T_IN + WC_T_OUT, extra);
                else phase_wconv(p, l + 1, lds, 0, WC_T_IN + WC_T_OUT, 0);
            }
        PHASE_END
        PHASE_BEGIN
#ifdef PROBE_CONV
            phase_conv(p, l, l == 0, true);
#endif
            phase_conv(p, l, l == 0);
        PHASE_END
        PHASE_BEGIN
            pg8::Gemm g{(const bf16_t*)(p.ws + WS_UZ) + DFF, (const bf16_t*)(p.ws + WS_WDN), Mrows, DM, DFF, DFF2};
            pg8::SplitTailOrder S; S.init(DM, gridDim.x, blockIdx.x, DFF, l == 0);
            pg8::EpiRes E{XB, XB + (size_t)RL * DM, XB, modl, 5 * DM, 1.0f, DFF / 64, (float*)(p.ws + WS_PART)};
#ifdef PROBE_RES
            { pg8::EpiRes E0{XB, XB + (size_t)RL * DM, XB, modl, 5 * DM, 0.0f, DFF / 64, (float*)(p.ws + WS_PART)}; pg8::gemm_phase(lds, g, S, E0); }
#endif
            pg8::gemm_phase(lds, g, S, E);
            if (l + 1 < NLAYER) {
                __syncthreads();
                phase_wconv(p, l + 1, lds, WC_T_IN + WC_T_OUT, WC_NODN, 0);
            }
        PHASE_END
    }
#ifdef EXTRA_SYNCS
    for (int i = 0; i < EXTRA_SYNCS; ++i) xcd_barrier(gbar);
#endif
    PHASE_BEGIN
        phase_final_norm(XB, p.g_final, p.out);
    PHASE_END
}
constexpr int N_PHASES = 1 + NLAYER * 10 + 1;

extern "C" void kernel_launch(void* const* d_in, const int* in_sizes, int n_in, void* d_out, int out_size, void* d_ws, size_t ws_size, hipStream_t stream) {
    static int grid = 0;
    if (grid == 0) {
        if (n_in != 20 || ws_size < WS_END) { fprintf(stderr, "kernel_launch: unexpected n_in %d or ws_size %zu (< %zu)\n", n_in, ws_size, (size_t)WS_END); grid = -1; return; }
        int dev = 0, cus = 0, per_cu = 0;
        hipGetDevice(&dev);
        hipDeviceGetAttribute(&cus, hipDeviceAttributeMultiprocessorCount, dev);
        if (hipFuncSetAttribute((const void*)mk_fwd, hipFuncAttributeMaxDynamicSharedMemorySize, LDS_BYTES) != hipSuccess) { fprintf(stderr, "kernel_launch: hipFuncSetAttribute failed\n"); grid = -1; return; }
        if (hipOccupancyMaxActiveBlocksPerMultiprocessor(&per_cu, (const void*)mk_fwd, 512, LDS_BYTES) != hipSuccess || per_cu < 1) { fprintf(stderr, "kernel_launch: occupancy query says %d\n", per_cu); per_cu = 1; }
        (void)hipGetLastError();
        grid = cus * 1;
        fprintf(stderr, "kernel_launch: cus %d per_cu %d grid %d ws %zu need %zu\n", cus, per_cu, grid, ws_size, (size_t)WS_END);
    }
    if (grid < 0) return;
    Params p{};
    const float** pp = (const float**)&p;
    for (int i = 0; i < 20; ++i) pp[i] = (const float*)d_in[i];
    p.out = (float*)d_out; p.ws = (unsigned char*)d_ws;
#if MULTI_LAUNCH
    for (int ph = 0; ph < N_PHASES; ++ph) {
        p.ph_lo = ph; p.ph_hi = ph + 1;
        hipLaunchKernelGGL(mk_fwd, dim3(grid), dim3(512), LDS_BYTES, stream, p);
    }
#else
    p.ph_lo = 0; p.ph_hi = N_PHASES;
    if (hipMemsetAsync((char*)d_ws + WS_BAR, 0, 16384, stream) != hipSuccess) { fprintf(stderr, "kernel_launch: memset of the barrier words failed\n"); return; }
    void* args[] = {&p};
    hipError_t e = hipLaunchCooperativeKernel((const void*)mk_fwd, dim3(grid), dim3(512), args, LDS_BYTES, stream);
    if (e != hipSuccess) fprintf(stderr, "cooperative launch failed: %s (grid %d)\n", hipGetErrorString(e), grid);
#endif
}
```

```cpp
#include <hip/hip_runtime.h>
#include <hip/hip_cooperative_groups.h>
#include <cstdio>
namespace cg = cooperative_groups;

#ifndef MULTI_LAUNCH
#define MULTI_LAUNCH 0
#endif


#ifndef REP_SCAN
#define REP_SCAN 1
#endif
#ifndef REP_GEMM
#define REP_GEMM 1
#endif
#ifndef REP_MISC
#define REP_MISC 1
#endif
#define LAS __attribute__((address_space(3)))
typedef unsigned short bf16_t;
typedef short bf16x8 __attribute__((ext_vector_type(8)));
typedef float f32x4 __attribute__((ext_vector_type(4)));
typedef unsigned u32x4 __attribute__((ext_vector_type(4)));
typedef unsigned u32x2 __attribute__((ext_vector_type(2)));

constexpr int DM = 2048, NB = 4, TL = 4096, TC = 256, NLAYER = 2;
constexpr int RL = NB * TL, RC = NB * TC, RT = RL + RC;
constexpr int PW = 6176, PWP = 6400, DFF = 5504, DFF2 = 11008;
constexpr int MODW = 6 * DM;
constexpr float EPS = 1e-6f;
constexpr int ZC_GQ = 0, ZC_GK = 512, ZC_GV = 1024, ZC_GG = 2048, ZC_MQ = 3072, ZC_MK = 3584, ZC_MV = 4096, ZC_MO = 5120, ZC_LR = 6144, ZC_MG = 6160;

constexpr size_t WS_UZ = 0;
constexpr size_t SZ_U = (size_t)RT * DFF2 * 2;
constexpr size_t WS_Z = WS_UZ;
constexpr size_t SZ_Z = (size_t)RT * PWP * 2;
constexpr size_t WS_O = WS_Z + SZ_Z;
constexpr size_t SZ_O1 = (size_t)RT * DM * 2;
static_assert(SZ_Z + 2 * SZ_O1 <= SZ_U, "overlay");
constexpr size_t WS_X = WS_UZ + SZ_U;
constexpr size_t WS_A = WS_X + (size_t)RT * DM * 4;
constexpr size_t WS_WIN = WS_A + (size_t)RT * DM * 2;
constexpr size_t WS_WOUT = WS_WIN + (size_t)PWP * DM * 2;
constexpr size_t WS_WUP = WS_WOUT + (size_t)DM * DM * 2;
constexpr size_t WS_WDN = WS_WUP + (size_t)DFF2 * DM * 2;
constexpr size_t WS_MOD = WS_WDN + (size_t)DM * DFF * 2;
constexpr size_t WS_BAR = WS_MOD + (size_t)NLAYER * 5 * MODW * 4;
constexpr size_t WS_EEND = WS_BAR + 16384;
constexpr size_t WS_PART = WS_EEND + (size_t)2 * (RT / 64) * 512 * 4;
constexpr size_t WS_MQK = WS_PART;
constexpr size_t SZ_MQK = (size_t)2 * RT * 512 * 2;
constexpr size_t WS_GATES = WS_PART + (SZ_MQK > (size_t)4 * RC * DM * 4 ? SZ_MQK : (size_t)4 * RC * DM * 4);
constexpr size_t WS_END = WS_GATES + (size_t)2 * 4 * 3 * RT * 4;

struct Params {
    const float *x, *c, *ctx, *c_ctx, *w_mod, *b_mod, *g_norm1, *g_norm2, *w_in, *gla_w_lr, *gla_b_lr, *mlstm_b_gate,
        *gla_g_norm, *mlstm_g_norm, *w_out, *w_up, *conv_w, *conv_b, *w_down, *g_final;
    float* out;
    unsigned char* ws;
    long long ph_lo, ph_hi;
};

__device__ __forceinline__ float bf2f(unsigned short h) { return __uint_as_float(((unsigned)h) << 16); }
__device__ __forceinline__ unsigned short f2bf(float f) { unsigned u = __float_as_uint(f); u += 0x7FFFu + ((u >> 16) & 1u); return (unsigned short)(u >> 16); }
typedef __bf16 bf16x2_t __attribute__((ext_vector_type(2)));
typedef float f32x2_t __attribute__((ext_vector_type(2)));
__device__ __forceinline__ unsigned cvt_pk_bf16(float lo, float hi) { const f32x2_t v = {lo, hi}; return __builtin_bit_cast(unsigned, __builtin_convertvector(v, bf16x2_t)); }
__device__ __forceinline__ float lo_bf(unsigned w) { return __uint_as_float(w << 16); }
__device__ __forceinline__ float hi_bf(unsigned w) { return __uint_as_float(w & 0xffff0000u); }
__device__ __forceinline__ float sigmoidf_(float x) { return __builtin_amdgcn_rcpf(1.0f + __expf(-x)); }
__device__ __forceinline__ float siluf_(float x) { return x * __builtin_amdgcn_rcpf(1.0f + __expf(-x)); }
__device__ __forceinline__ float logsigf_(float x) { return fminf(x, 0.f) - __logf(1.0f + __expf(-fabsf(x))); }
__device__ __forceinline__ int otid() { int t = threadIdx.x; asm volatile("" : "+v"(t)); return t; }
template <int CTRL, int RM> __device__ __forceinline__ float dpp_f(float v, float old) {
    return __int_as_float(__builtin_amdgcn_update_dpp(__float_as_int(old), __float_as_int(v), CTRL, RM, 0xF, false));
}
__device__ __forceinline__ float wave_incl_sum(float v) {
    v += dpp_f<0x111, 0xF>(v, 0.f); v += dpp_f<0x112, 0xF>(v, 0.f); v += dpp_f<0x114, 0xF>(v, 0.f); v += dpp_f<0x118, 0xF>(v, 0.f);
    v += dpp_f<0x142, 0xA>(v, 0.f); v += dpp_f<0x143, 0xC>(v, 0.f); return v;
}
__device__ __forceinline__ float wave_incl_max(float v) {
    const float ninf = __int_as_float(0xff800000);
    v = fmaxf(v, dpp_f<0x111, 0xF>(v, ninf)); v = fmaxf(v, dpp_f<0x112, 0xF>(v, ninf)); v = fmaxf(v, dpp_f<0x114, 0xF>(v, ninf)); v = fmaxf(v, dpp_f<0x118, 0xF>(v, ninf));
    v = fmaxf(v, dpp_f<0x142, 0xA>(v, ninf)); v = fmaxf(v, dpp_f<0x143, 0xC>(v, ninf)); return v;
}
__device__ __forceinline__ float rdlane63(float v) { return __int_as_float(__builtin_amdgcn_readlane(__float_as_int(v), 63)); }
__device__ __forceinline__ float wave_sum(float v) { return rdlane63(wave_incl_sum(v)); }
__device__ __forceinline__ float wave_max(float v) { return rdlane63(wave_incl_max(v)); }


#define XB_TMO      128
#define XB_XCNT(j)  (256  + 64 * (j))
#define XB_XSUB(j)  (1280 + 64 * (j))
#define XB_XGEN(j)  (2304 + 64 * (j))
#define XB_TOP      3328
#define XB_TOPGEN   3392
#define XCD_BAR_WORDS 3456
#define XB_SPIN_CAP (1u << 22)
__device__ __forceinline__ unsigned xb_ld(unsigned* p)              { return __hip_atomic_load(p, __ATOMIC_RELAXED, __HIP_MEMORY_SCOPE_AGENT); }
__device__ __forceinline__ unsigned xb_add(unsigned* p, unsigned v) { return __hip_atomic_fetch_add(p, v, __ATOMIC_RELAXED, __HIP_MEMORY_SCOPE_AGENT); }
__device__ __forceinline__ unsigned xb_xcc_id() { return (unsigned)__builtin_amdgcn_s_getreg((3 << 11) | 20) & 0xFu; }
#define XB_SPIN(cond, bar) do { unsigned _sp = 0; while (cond) { __builtin_amdgcn_s_sleep(1); \
    if ((++_sp & 255u) == 0u) { if (xb_ld(&(bar)[XB_TMO])) break; if (_sp > XB_SPIN_CAP) { atomicAdd(&(bar)[XB_TMO], 1u); break; } } } } while (0)
struct XcdBarrier { unsigned* bar; unsigned x; volatile LAS unsigned* st; };
__device__ __forceinline__ XcdBarrier xcd_barrier_post(unsigned* bar, volatile LAS unsigned* st) {
    XcdBarrier b; b.bar = bar; b.x = xb_xcc_id(); b.st = st;
    if (threadIdx.x == 0) (void)xb_add(&bar[XB_XCNT(b.x)], 1u);
    return b;
}
__device__ __forceinline__ void xcd_barrier_complete(unsigned* bar, unsigned x, unsigned& nloc, unsigned& nx) {
    const unsigned G = gridDim.x * gridDim.y * gridDim.z;
    unsigned sum, cnt, mine, sp = 0u;
    for (;;) {
        sum = 0u; cnt = 0u; mine = 0u;
#pragma unroll
        for (unsigned j = 0; j < 16; ++j) { const unsigned c = xb_ld(&bar[XB_XCNT(j)]); sum += c; cnt += (c > 0u) ? 1u : 0u; mine = (j == x) ? c : mine; }
        if (sum == G) break;
        __builtin_amdgcn_s_sleep(1);
        if ((++sp & 255u) == 0u) { if (xb_ld(&bar[XB_TMO])) break; if (sp > XB_SPIN_CAP) { atomicAdd(&bar[XB_TMO], 1u); break; } }
    }
    nloc = mine > 0u ? mine : 1u; nx = cnt > 0u ? cnt : 1u;
}
__device__ __forceinline__ void xcd_barrier(const XcdBarrier& b) {
    asm volatile("s_waitcnt vmcnt(0)" ::: "memory");
    __syncthreads();
    if (threadIdx.x == 0) {
        unsigned* bar = b.bar;
        __builtin_amdgcn_s_waitcnt(0);
        unsigned nloc = b.st[0], nx = b.st[1];
        if (nloc == 0u) { xcd_barrier_complete(bar, b.x, nloc, nx); b.st[0] = nloc; b.st[1] = nx; }
        const unsigned old = xb_add(&bar[XB_XSUB(b.x)], 1u);
        const unsigned gen = old / nloc;
        if (old + 1u == (gen + 1u) * nloc) {
            __builtin_amdgcn_fence(__ATOMIC_RELEASE, "agent");
            asm volatile("s_waitcnt vmcnt(0)" ::: "memory");
            const unsigned og = xb_add(&bar[XB_TOP], 1u);
            const unsigned tg = og / nx;
            if (og + 1u == (tg + 1u) * nx) xb_add(&bar[XB_TOPGEN], 1u);
            else XB_SPIN(xb_ld(&bar[XB_TOPGEN]) == tg, bar);
            __builtin_amdgcn_fence(__ATOMIC_ACQUIRE, "agent");
            xb_add(&bar[XB_XGEN(b.x)], 1u);
            asm volatile("s_waitcnt vmcnt(0)" ::: "memory");
        } else {
            XB_SPIN(xb_ld(&bar[XB_XGEN(b.x)]) == gen, bar);
            __builtin_amdgcn_fence(__ATOMIC_ACQUIRE, "agent");
            asm volatile("s_waitcnt vmcnt(0)" ::: "memory");
        }
    }
    __syncthreads();
}

namespace pg8 {
constexpr int BM = 256, BK = 64, HALF = 128, HTB = HALF * BK * 2, STAGE_BYTES = 8 * HTB, NXCD = 8, WGM = 4;
__host__ __device__ __forceinline__ int lds_byte(int r, int c) { const int st = (r >> 4) * 2 + (c >> 5), rr = r & 15, cc = c & 31, ob = rr * 64 + cc * 2; return st * 1024 + (ob ^ (((ob >> 9) & 1) << 5)); }
__host__ __device__ __forceinline__ void stage_rc(int b, int& R, int& C) { const int st = b / 1024, sb = b % 1024, swz = sb ^ (((sb >> 9) & 1) << 5); R = (st >> 1) * 16 + swz / 64; C = (st & 1) * 32 + (swz % 64) / 2; }
__host__ __device__ __forceinline__ int perm32(int rho) { const int n = rho >> 4, i = rho & 15; return 8 * (i >> 2) + 4 * n + (i & 3); }
struct Unit { int pm, pn, kt0, nt, piece; };
struct Gemm { const bf16_t* A; const bf16_t* Bt; int M, N, K, lda; };
struct StaticOrder {
    int nM, nN, nwg, G, c, ntK;
    __host__ __device__ void init(int M, int N, int G_, int c_, int K_ = 0) { nM = M / BM; nN = N / BM; nwg = nM * nN; G = G_; c = c_; ntK = K_ / BK; }
    __host__ __device__ bool next(int i, Unit& u) const {
        const long L = (long)i * G + c; if (L >= nwg) return false;
        int wgid = (int)L;
#ifndef NO_XCD_REMAP
        { const int q = nwg / NXCD, r = nwg % NXCD, xcd = wgid % NXCD, off = wgid / NXCD; wgid = (xcd < r ? xcd * (q + 1) : r * (q + 1) + (xcd - r) * q) + off; }
#endif
        const int nig = WGM * nN, gid = wgid / nig, fm = gid * WGM, gsz = (nM - fm) < WGM ? (nM - fm) : WGM;
        u.pm = fm + ((wgid % nig) % gsz); u.pn = (wgid % nig) / gsz; u.kt0 = 0; u.nt = ntK; u.piece = 0; return true;
    }
};
struct SplitTailOrder {
    StaticOrder lat; int ntK, nlat, npieces;
    __host__ __device__ void init(int N, int G_, int c_, int K_, bool with_ctx) { lat.init(RL, N, G_, c_, K_); ntK = K_ / BK; nlat = lat.nwg; npieces = with_ctx ? 32 * 4 : 0; }
    __host__ __device__ bool next(int i, Unit& u) const {
        const long L = (long)i * lat.G + lat.c;
        u.pm = 0; u.pn = 0; u.kt0 = 0; u.nt = ntK; u.piece = 0;
        if (L < nlat) { Unit t; t.pm = 0; t.pn = 0; t.kt0 = 0; t.nt = ntK; t.piece = 0; const bool ok = lat.next(i, t); u.pm = t.pm; u.pn = t.pn; return ok; }
        const int q = (int)(L - nlat); if (q >= npieces) return false;
        const int uu = q >> 2, piece = q & 3;
        u.pm = 64 + (uu >> 3); u.pn = uu & 7; u.piece = piece;
        const int nb = ntK / 2;
        const int base = nb / 4, rem = nb % 4;
        const int b0 = piece * base + (piece < rem ? piece : rem), nbp = base + (piece < rem ? 1 : 0);
        u.kt0 = 2 * b0; u.nt = 2 * nbp; return true;
    }
};

struct EpiBf16 {
    static constexpr bool PERM = true;
    bf16_t* O; int ldc;
    __device__ __forceinline__ void operator()(const f32x4 (&acc)[2][2][4][2], const Unit& u, int wr, int wc, int fr, int fq) const {
        const int row0 = u.pm * BM + wr * 64 + fr; const int col0 = u.pn * BM + wc * 32 + 8 * fq;
#pragma unroll
        for (int ai = 0; ai < 2; ++ai)
#pragma unroll
            for (int m = 0; m < 4; ++m) { bf16_t* rowp = O + (size_t)(row0 + ai * HALF + m * 16) * ldc + col0;
#pragma unroll
                for (int bj = 0; bj < 2; ++bj) { const f32x4 v0 = acc[ai][bj][m][0], v1 = acc[ai][bj][m][1];
                    u32x4 w; w.x = cvt_pk_bf16(v0[0], v0[1]); w.y = cvt_pk_bf16(v0[2], v0[3]); w.z = cvt_pk_bf16(v1[0], v1[1]); w.w = cvt_pk_bf16(v1[2], v1[3]);
                    __builtin_nontemporal_store(w, (u32x4*)(rowp + bj * HALF)); } }
    }
};
struct EpiRes {
    static constexpr bool PERM = false;
    const float* base_lat; const float* base_ctx; float* out; const float* mod; int gt_off; float scale; int ntK; float* part;
    __device__ __forceinline__ void operator()(const f32x4 (&acc)[2][2][4][2], const Unit& u, int wr, int wc, int fr, int fq) const {
        const int bidx = u.pm < 64 ? (u.pm >> 4) : 4;
        const bool split = u.nt < ntK;
        const float* gt = mod + (size_t)bidx * MODW + gt_off;
        const int row0 = u.pm * BM + wr * 64 + fr, col0 = u.pn * BM + wc * 32 + 4 * fq;
        const float* bbase = u.pm < 64 ? base_lat : (base_ctx - (size_t)RL * DM);
        f32x4 gv[2][2];
#pragma unroll
        for (int bj = 0; bj < 2; ++bj)
#pragma unroll
            for (int n = 0; n < 2; ++n) gv[bj][n] = *(const f32x4*)(gt + col0 + bj * HALF + n * 16) * scale;
        if (split) {
#pragma unroll
            for (int ai = 0; ai < 2; ++ai)
#pragma unroll
                for (int m = 0; m < 4; ++m) { const size_t off = (size_t)(row0 + ai * HALF + m * 16) * DM + col0;
#pragma unroll
                    for (int bj = 0; bj < 2; ++bj)
#pragma unroll
                        for (int n = 0; n < 2; ++n) *(f32x4*)(part + (size_t)u.piece * RC * DM + (off - (size_t)RL * DM) + bj * HALF + n * 16) = gv[bj][n] * acc[ai][bj][m][n]; }
        } else {
#pragma unroll
            for (int ai = 0; ai < 2; ++ai)
                {
                    f32x4 bs[4][2][2];
#pragma unroll
                    for (int mm = 0; mm < 4; ++mm) { const size_t off = (size_t)(row0 + ai * HALF + mm * 16) * DM + col0;
#pragma unroll
                        for (int bj = 0; bj < 2; ++bj)
#pragma unroll
                            for (int n = 0; n < 2; ++n) bs[mm][bj][n] = *(const f32x4*)(bbase + off + bj * HALF + n * 16); }
#pragma unroll
                    for (int mm = 0; mm < 4; ++mm) { const size_t off = (size_t)(row0 + ai * HALF + mm * 16) * DM + col0;
#pragma unroll
                        for (int bj = 0; bj < 2; ++bj)
#pragma unroll
                            for (int n = 0; n < 2; ++n) *(f32x4*)(out + off + bj * HALF + n * 16) = bs[mm][bj][n] + gv[bj][n] * acc[ai][bj][mm][n]; }
                    asm volatile("" ::: "memory"); }
        }
        __builtin_amdgcn_s_waitcnt(0x0F70);
    }
};

#ifndef PG8_SP2
#define PG8_SP2 true
#endif
#ifndef PG8_ALIGN
#define PG8_ALIGN true
#endif
template <class Epi, class Sched, bool SP2 = PG8_SP2, bool ALIGN_EPI = PG8_ALIGN>
__device__ __forceinline__ void gemm_phase(LAS unsigned char* lds, const Gemm g, const Sched& S, const Epi& E) {
    int tid = threadIdx.x; asm volatile("" : "+v"(tid));
    const int wid = __builtin_amdgcn_readfirstlane(tid >> 6), lane = tid & 63, wr = wid >> 2, wc = wid & 3, fr = lane & 15, fq = lane >> 4;
    const int K = g.K, lda = g.lda;
    unsigned voffA[2], voffB[2];
#pragma unroll
    for (int i = 0; i < 2; ++i) { int R, C; stage_rc(tid * 16 + i * 8192, R, C); const int Rb = Epi::PERM ? ((R & ~31) + perm32(R & 31)) : R;
        voffA[i] = (unsigned)(R * lda + C) * 2u; voffB[i] = (unsigned)(Rb * K + C) * 2u; }
    const size_t kstep = (size_t)(BK * 2);
    const size_t hstepA = (size_t)HALF * lda * 2, hstepB = (size_t)HALF * K * 2;
    const size_t tstepA = 2 * hstepA, tstepB = 2 * hstepB;
    const unsigned ldsw = (unsigned)wid * 1024u;
    const int aoff = lds_byte(wr * 64 + fr, fq * 8), boff = lds_byte(wc * 32 + fr, fq * 8);
#define PG8_SA(b, h) (((b) * 2 + (h)) * HTB)
#define PG8_SB(b, h) ((4 + (b) * 2 + (h)) * HTB)
#define PG8_STAGE(bufoff, gbase, voff) do { _Pragma("unroll") for (int _i = 0; _i < 2; ++_i) \
        __builtin_amdgcn_global_load_lds((const unsigned*)((const char*)(gbase) + (voff)[_i]), (LAS unsigned*)(lds + (bufoff) + ldsw + _i * 8192), 16, 0, 0); } while (0)
#define PG8_LDA(dst, b, h) do { _Pragma("unroll") for (int m = 0; m < 4; ++m) _Pragma("unroll") for (int k = 0; k < 2; ++k) dst[m][k] = *(const LAS bf16x8*)(lds + PG8_SA(b, h) + aoff + m * 2048 + k * 1024); } while (0)
#define PG8_LDB(dst, b, h) do { _Pragma("unroll") for (int n = 0; n < 2; ++n) _Pragma("unroll") for (int k = 0; k < 2; ++k) dst[n][k] = *(const LAS bf16x8*)(lds + PG8_SB(b, h) + boff + n * 2048 + k * 1024); } while (0)
#define PG8_MMA(ai, bj, At, Bt) do { __builtin_amdgcn_s_setprio(1); _Pragma("unroll") for (int m = 0; m < 4; ++m) _Pragma("unroll") for (int n = 0; n < 2; ++n) _Pragma("unroll") for (int k = 0; k < 2; ++k) \
        acc[ai][bj][m][n] = __builtin_amdgcn_mfma_f32_16x16x32_bf16(Bt[n][k], At[m][k], acc[ai][bj][m][n], 0, 0, 0); __builtin_amdgcn_s_setprio(0); } while (0)
#define PG8_WAIT_V(n) asm volatile("s_waitcnt vmcnt(" #n ")" ::: "memory")
#define PG8_WAIT_L(n) asm volatile("s_waitcnt lgkmcnt(" #n ")" ::: "memory")
#define PG8_BAR __builtin_amdgcn_s_barrier()
#define PG8_SCHED __builtin_amdgcn_sched_barrier(0)
    Unit cur, nxt; int ui = 0;
    if (!S.next(0, cur)) return;
    f32x4 acc[2][2][4][2];
#pragma unroll
    for (int a = 0; a < 2; ++a)
#pragma unroll
        for (int b = 0; b < 2; ++b)
#pragma unroll
            for (int m = 0; m < 4; ++m)
#pragma unroll
                for (int n = 0; n < 2; ++n) acc[a][b][m][n] = (f32x4){0.f, 0.f, 0.f, 0.f};
    bf16x8 At[4][2], B0[2][2], B1[2][2];
    const char* cA = (const char*)g.A + (size_t)cur.pm * tstepA + (size_t)cur.kt0 * kstep; const char* cB = (const char*)g.Bt + (size_t)cur.pn * tstepB + (size_t)cur.kt0 * kstep;
    if constexpr (SP2) {
        PG8_STAGE(PG8_SB(0, 0), cB, voffB); PG8_STAGE(PG8_SB(0, 1), cB + hstepB, voffB); PG8_STAGE(PG8_SA(0, 0), cA, voffA); PG8_STAGE(PG8_SA(0, 1), cA + hstepA, voffA);
        if (wr == 1) PG8_BAR;
        PG8_WAIT_V(2); PG8_BAR;
        PG8_STAGE(PG8_SB(1, 0), cB + kstep, voffB); PG8_STAGE(PG8_SA(1, 0), cA + kstep, voffA); PG8_STAGE(PG8_SB(1, 1), cB + hstepB + kstep, voffB);
        PG8_WAIT_V(6); PG8_BAR;
    } else {
    PG8_STAGE(PG8_SB(0, 0), cB, voffB); PG8_STAGE(PG8_SA(0, 0), cA, voffA); PG8_STAGE(PG8_SB(0, 1), cB + hstepB, voffB); PG8_STAGE(PG8_SA(0, 1), cA + hstepA, voffA);
    if (wr == 1) PG8_BAR;
    PG8_WAIT_V(4); PG8_BAR;
    PG8_STAGE(PG8_SB(1, 0), cB + kstep, voffB); PG8_STAGE(PG8_SA(1, 0), cA + kstep, voffA); PG8_STAGE(PG8_SB(1, 1), cB + hstepB + kstep, voffB);
    PG8_WAIT_V(6); PG8_BAR;
    }
    for (;;) {
        const bool has_next = S.next(ui + 1, nxt);
        const char* nA = has_next ? (const char*)g.A + (size_t)nxt.pm * tstepA + (size_t)nxt.kt0 * kstep : cA; const char* nB = has_next ? (const char*)g.Bt + (size_t)nxt.pn * tstepB + (size_t)nxt.kt0 * kstep : cB;
        const int nt = cur.nt;
        for (int t = 0; t < nt; t += 2) {
            const bool last = (t == nt - 2);
            const char* a1 = cA + (size_t)(t + 1) * kstep;
            const char* a2 = last ? nA : cA + (size_t)(t + 2) * kstep; const char* b2 = last ? nB : cB + (size_t)(t + 2) * kstep;
            const char* a3 = a2 + kstep; const char* b3 = b2 + kstep;
            if constexpr (SP2) {
            PG8_LDB(B0, 0, 0); PG8_LDB(B1, 0, 1); PG8_SCHED; PG8_LDA(At, 0, 0); PG8_STAGE(PG8_SA(1, 1), a1 + hstepA, voffA);
            PG8_WAIT_V(8); PG8_WAIT_L(0); PG8_BAR; PG8_MMA(0, 0, At, B0); PG8_MMA(0, 1, At, B1); PG8_BAR; PG8_SCHED;
            PG8_LDA(At, 0, 1); PG8_STAGE(PG8_SB(0, 0), b2, voffB); PG8_STAGE(PG8_SB(0, 1), b2 + hstepB, voffB); PG8_STAGE(PG8_SA(0, 0), a2, voffA);
            PG8_WAIT_V(8); PG8_WAIT_L(0); PG8_BAR; PG8_MMA(1, 0, At, B0); PG8_MMA(1, 1, At, B1); PG8_BAR; PG8_SCHED;
            PG8_LDB(B0, 1, 0); PG8_LDB(B1, 1, 1); PG8_SCHED; PG8_LDA(At, 1, 0); PG8_STAGE(PG8_SA(0, 1), a2 + hstepA, voffA);
            PG8_WAIT_V(8); PG8_WAIT_L(0); PG8_BAR; PG8_MMA(0, 0, At, B0); PG8_MMA(0, 1, At, B1); PG8_BAR; PG8_SCHED;
            PG8_LDA(At, 1, 1); PG8_STAGE(PG8_SB(1, 0), b3, voffB); PG8_STAGE(PG8_SB(1, 1), b3 + hstepB, voffB); PG8_STAGE(PG8_SA(1, 0), a3, voffA);
            PG8_WAIT_V(8); PG8_WAIT_L(0); PG8_BAR; PG8_MMA(1, 0, At, B0); PG8_MMA(1, 1, At, B1); PG8_BAR; PG8_SCHED;
            } else {
            PG8_LDB(B0, 0, 0); PG8_SCHED; PG8_LDA(At, 0, 0); PG8_STAGE(PG8_SA(1, 1), a1 + hstepA, voffA);
            PG8_WAIT_L(8); PG8_BAR; PG8_WAIT_L(0); PG8_MMA(0, 0, At, B0); PG8_BAR; PG8_SCHED;
            PG8_LDB(B1, 0, 1); PG8_STAGE(PG8_SB(0, 0), b2, voffB);
            PG8_BAR; PG8_WAIT_L(0); PG8_MMA(0, 1, At, B1); PG8_BAR;
            PG8_LDA(At, 0, 1); PG8_STAGE(PG8_SA(0, 0), a2, voffA);
            PG8_BAR; PG8_WAIT_L(0); PG8_MMA(1, 0, At, B0); PG8_BAR; PG8_SCHED;
            PG8_STAGE(PG8_SB(0, 1), b2 + hstepB, voffB);
            PG8_WAIT_V(6); PG8_BAR; PG8_MMA(1, 1, At, B1); PG8_BAR;
            PG8_LDB(B0, 1, 0); PG8_SCHED; PG8_LDA(At, 1, 0); PG8_STAGE(PG8_SA(0, 1), a2 + hstepA, voffA);
            PG8_WAIT_L(8); PG8_BAR; PG8_WAIT_L(0); PG8_MMA(0, 0, At, B0); PG8_BAR; PG8_SCHED;
            PG8_LDB(B1, 1, 1); PG8_STAGE(PG8_SB(1, 0), b3, voffB);
            PG8_BAR; PG8_WAIT_L(0); PG8_MMA(0, 1, At, B1); PG8_BAR;
            PG8_LDA(At, 1, 1); PG8_STAGE(PG8_SA(1, 0), a3, voffA);
            PG8_BAR; PG8_WAIT_L(0); PG8_MMA(1, 0, At, B0); PG8_BAR; PG8_SCHED;
            PG8_STAGE(PG8_SB(1, 1), b3 + hstepB, voffB);
            PG8_WAIT_V(6); PG8_BAR; PG8_MMA(1, 1, At, B1); PG8_BAR;
            }
        }
        if constexpr (ALIGN_EPI) { if (wr == 0) PG8_BAR; }
        E(acc, cur, wr, wc, fr, fq);
        if (!has_next) break;
#pragma unroll
        for (int a = 0; a < 2; ++a)
#pragma unroll
            for (int b = 0; b < 2; ++b)
#pragma unroll
                for (int m = 0; m < 4; ++m)
#pragma unroll
                    for (int n = 0; n < 2; ++n) acc[a][b][m][n] = (f32x4){0.f, 0.f, 0.f, 0.f};
        cur = nxt; cA = nA; cB = nB; ++ui;
        if constexpr (ALIGN_EPI) { if (wr == 1) PG8_BAR; }
    }
    PG8_WAIT_V(0);
    if constexpr (!ALIGN_EPI) { if (wr == 0) PG8_BAR; }
    PG8_BAR;
#undef PG8_SA
#undef PG8_SB
#undef PG8_STAGE
#undef PG8_LDA
#undef PG8_LDB
#undef PG8_MMA
#undef PG8_WAIT_V
#undef PG8_WAIT_L
#undef PG8_BAR
#undef PG8_SCHED
}
}

constexpr int LDS_BYTES = pg8::STAGE_BYTES + 16;

__device__ __forceinline__ void phase_mod(const Params& p, LAS unsigned char* lds) {
    LAS float* act = (LAS float*)lds;
    LAS float* part = (LAS float*)(lds + 40960);
    const int tid = otid();
    for (int i = tid; i < 5 * DM; i += 512) { const int r = i / DM, k = i % DM; const float v = r < 4 ? p.c[r * DM + k] : p.c_ctx[k]; act[i] = siluf_(v); }
    __syncthreads();
    float* modout = (float*)(p.ws + WS_MOD);
    for (int unit = blockIdx.x; unit < 2 * 128; unit += gridDim.x) {
        const int l = unit >> 7, n0 = (unit & 127) * 96;
        const int c4 = tid % 24, kg = tid / 24;
        f32x4 a0 = {0, 0, 0, 0}, a1 = a0, a2 = a0, a3 = a0, a4 = a0;
        if (kg < 21) {
            const float* wp = p.w_mod + (size_t)l * DM * MODW + n0 + c4 * 4;
            for (int k0 = kg; k0 < DM; k0 += 21 * 7) {
                f32x4 w[7]; int kk[7]; float ok[7];
#pragma unroll
                for (int u = 0; u < 7; ++u) { const int k = k0 + 21 * u; const bool in = k < DM; kk[u] = in ? k : kg; ok[u] = in ? 1.0f : 0.0f; w[u] = *(const f32x4*)(wp + (size_t)kk[u] * MODW); }
#pragma unroll
                for (int u = 0; u < 7; ++u) { const f32x4 wu = w[u] * ok[u]; const int k = kk[u];
                    a0 += act[k] * wu; a1 += act[DM + k] * wu; a2 += act[2 * DM + k] * wu; a3 += act[3 * DM + k] * wu; a4 += act[4 * DM + k] * wu; }
            }
            LAS float* pp = part + kg * 480 + c4 * 4;
            *(LAS f32x4*)(pp) = a0; *(LAS f32x4*)(pp + 96) = a1; *(LAS f32x4*)(pp + 192) = a2; *(LAS f32x4*)(pp + 288) = a3; *(LAS f32x4*)(pp + 384) = a4;
        }
        __syncthreads();
        if (tid < 480) {
            const int r = tid / 96, cc = tid % 96; float s = p.b_mod[l * MODW + n0 + cc];
            for (int g = 0; g < 21; ++g) s += part[g * 480 + tid];
            modout[((size_t)l * 5 + r) * MODW + n0 + cc] = s;
        }
        __syncthreads();
    }
}

__device__ __forceinline__ void wconv_tile(const float* src, bf16_t* dst, int K, int N, int k0, int n0, bool is_win, LAS float* tile) {
    const int tid = otid();
    {
        const int r = tid >> 4, c4 = tid & 15;
        f32x4 v[4][2];
#pragma unroll
        for (int j = 0; j < 4; ++j) {
            const int n = n0 + j * 64 + c4 * 4; int on = n;
            if (is_win) { if (n >= 6176) on = -1; else if (n >= 6160) on = n; else if (n >= 6144) on = 3072 + (n - 6144); else if (n >= 3072) on = n + 16; }
#pragma unroll
            for (int rr = 0; rr < 2; ++rr) {
                v[j][rr] = (f32x4){0.f, 0.f, 0.f, 0.f};
                if (on >= 0) v[j][rr] = *(const f32x4*)(src + (size_t)(k0 + r + rr * 32) * N + on);
            }
        }
#pragma unroll
        for (int j = 0; j < 4; ++j)
#pragma unroll
            for (int rr = 0; rr < 2; ++rr) {
                const int k = r + rr * 32; LAS float* tp = tile + (j * 64 + c4 * 4) * 65 + k;
                tp[0] = v[j][rr][0]; tp[65] = v[j][rr][1]; tp[130] = v[j][rr][2]; tp[195] = v[j][rr][3];
            }
    }
    __syncthreads();
#pragma unroll
    for (int q = 0; q < 4; ++q) {
        const int n = q * 64 + (tid >> 3), seg = tid & 7;
        const LAS float* tp = tile + n * 65 + seg * 8;
        u32x4 w; w.x = cvt_pk_bf16(tp[0], tp[1]); w.y = cvt_pk_bf16(tp[2], tp[3]); w.z = cvt_pk_bf16(tp[4], tp[5]); w.w = cvt_pk_bf16(tp[6], tp[7]);
        *(u32x4*)(dst + (size_t)(n0 + n) * K + k0 + seg * 8) = w;
    }
    __syncthreads();
}
constexpr int WC_T_IN = 32 * 25, WC_T_OUT = 32 * 8, WC_T_UP = 32 * 43, WC_T_DN = 86 * 8;
constexpr int WC_TOT = WC_T_IN + WC_T_OUT + WC_T_UP + WC_T_DN, WC_NODN = WC_T_IN + WC_T_OUT + WC_T_UP, WC_TAIL0 = 600;
__device__ __forceinline__ void phase_wconv(const Params& p, int l, LAS unsigned char* lds, int t_begin = 0, int t_end = WC_TOT, int first_block = 0) {
    LAS float* tile = (LAS float*)lds;
    constexpr int T_IN = WC_T_IN, T_OUT = WC_T_OUT, T_UP = WC_T_UP;
    if ((int)blockIdx.x < first_block) return;
    for (int t = t_begin + (int)blockIdx.x - first_block; t < t_end; t += (int)gridDim.x - first_block) {
        if (t < T_IN) { const int kt = t % 32, ntile = t / 32; wconv_tile(p.w_in + (size_t)l * DM * PW, (bf16_t*)(p.ws + WS_WIN), DM, PW, kt * 64, ntile * 256, true, tile); }
        else if (t < T_IN + T_OUT) { const int u = t - T_IN; const int kt = u % 32, ntile = u / 32; wconv_tile(p.w_out + (size_t)l * DM * DM, (bf16_t*)(p.ws + WS_WOUT), DM, DM, kt * 64, ntile * 256, false, tile); }
        else if (t < T_IN + T_OUT + T_UP) { const int u = t - T_IN - T_OUT; const int kt = u % 32, ntile = u / 32; wconv_tile(p.w_up + (size_t)l * DM * DFF2, (bf16_t*)(p.ws + WS_WUP), DM, DFF2, kt * 64, ntile * 256, false, tile); }
        else { const int u = t - T_IN - T_OUT - T_UP; const int kt = u % 86, ntile = u / 86; wconv_tile(p.w_down + (size_t)l * DFF * DM, (bf16_t*)(p.ws + WS_WDN), DFF, DM, kt * 64, ntile * 256, false, tile); }
    }
}

__device__ __forceinline__ void phase_norm(const float* src_lat, const float* src_ctx, const float* g, const float* mod, int sh_off, int sc_off, int nrows, bf16_t* dst, const float* part = nullptr, float* ctx_wb = nullptr) {
    const int tid_ = otid(); const int lane = tid_ & 63, wv = tid_ >> 6;
    for (int row = blockIdx.x * 8 + wv; row < nrows; row += gridDim.x * 8) {
        const float* xr = row < RL ? src_lat + (size_t)row * DM : src_ctx + (size_t)(row - RL) * DM;
        const int bidx = row < RL ? (row >> 12) : 4;
        const float* mr = mod + (size_t)bidx * MODW;
        f32x4 v[8]; float ss = 0.f;
#pragma unroll
        for (int it = 0; it < 8; ++it) { v[it] = *(const f32x4*)(xr + (it * 64 + lane) * 4); }
        if (part != nullptr && row >= RL) {
            const float* pr = part + (size_t)(row - RL) * DM; float* wb = ctx_wb + (size_t)(row - RL) * DM;
#pragma unroll
            for (int it = 0; it < 8; ++it) { const int col = (it * 64 + lane) * 4;
                v[it] += (*(const f32x4*)(pr + col) + *(const f32x4*)(pr + (size_t)RC * DM + col)) + (*(const f32x4*)(pr + (size_t)2 * RC * DM + col) + *(const f32x4*)(pr + (size_t)3 * RC * DM + col));
                *(f32x4*)(wb + col) = v[it]; }
        }
#pragma unroll
        for (int it = 0; it < 8; ++it) ss += v[it][0] * v[it][0] + v[it][1] * v[it][1] + v[it][2] * v[it][2] + v[it][3] * v[it][3];
        f32x4 pg[8], psc[8], psh[8];
#pragma unroll
        for (int it = 0; it < 8; ++it) { const int col = (it * 64 + lane) * 4; pg[it] = *(const f32x4*)(g + col); psc[it] = *(const f32x4*)(mr + sc_off + col); psh[it] = *(const f32x4*)(mr + sh_off + col); }
        ss = wave_sum(ss);
        const float rstd = rsqrtf(ss * (1.0f / DM) + EPS);
#pragma unroll
        for (int it = 0; it < 8; ++it) {
            const int col = (it * 64 + lane) * 4;
            const f32x4 h = v[it] * rstd * pg[it] * (1.0f + psc[it]) + psh[it];
            u32x2 w; w.x = cvt_pk_bf16(h[0], h[1]); w.y = cvt_pk_bf16(h[2], h[3]);
            *(u32x2*)(dst + (size_t)row * DM + col) = w;
        }
    }
}
__device__ __forceinline__ void phase_final_norm(const float* src, const float* g, float* out) {
    const int tid_ = otid(); const int lane = tid_ & 63, wv = tid_ >> 6;
    for (int row = blockIdx.x * 8 + wv; row < RL; row += gridDim.x * 8) {
        const float* xr = src + (size_t)row * DM;
        f32x4 v[8]; float ss = 0.f;
#pragma unroll
        for (int it = 0; it < 8; ++it) { v[it] = *(const f32x4*)(xr + (it * 64 + lane) * 4); ss += v[it][0] * v[it][0] + v[it][1] * v[it][1] + v[it][2] * v[it][2] + v[it][3] * v[it][3]; }
        f32x4 pg[8];
#pragma unroll
        for (int it = 0; it < 8; ++it) pg[it] = *(const f32x4*)(g + (it * 64 + lane) * 4);
        ss = wave_sum(ss);
        const float rstd = rsqrtf(ss * (1.0f / DM) + EPS);
#pragma unroll
        for (int it = 0; it < 8; ++it) { const int col = (it * 64 + lane) * 4; *(f32x4*)(out + (size_t)row * DM + col) = v[it] * rstd * pg[it]; }
    }
}

__device__ __forceinline__ void phase_merge(const Params& p, int l, int nrows) {
    const bf16_t* Z = (const bf16_t*)(p.ws + WS_Z);
    const bf16_t* O0 = (const bf16_t*)(p.ws + WS_O);
    const bf16_t* O1 = (const bf16_t*)(p.ws + WS_O + SZ_O1);
    bf16_t* Y = (bf16_t*)(p.ws + WS_A);
    const int tid_ = otid(); const int lane = tid_ & 63, wv = tid_ >> 6;
    const f32x4 gg = *(const f32x4*)(p.gla_g_norm + l * 256 + lane * 4), gm = *(const f32x4*)(p.mlstm_g_norm + l * 256 + lane * 4);
    for (int row = blockIdx.x * 8 + wv; row < nrows; row += gridDim.x * 8) {
        u32x2 oa[8], ob[8], og[8];
#pragma unroll
        for (int hd = 0; hd < 8; ++hd) {
            const int col = hd * 256 + lane * 4;
            const int gcol = hd < 4 ? (ZC_GG + hd * 256 + lane * 4) : (ZC_MO + (hd - 4) * 256 + lane * 4);
            oa[hd] = *(const u32x2*)(O0 + (size_t)row * DM + col); ob[hd] = *(const u32x2*)(O1 + (size_t)row * DM + col); og[hd] = *(const u32x2*)(Z + (size_t)row * PWP + gcol);
        }
#pragma unroll
        for (int hd = 0; hd < 8; ++hd) {
            const int col = hd * 256 + lane * 4;
            const u32x2 a = oa[hd], b = ob[hd], gz = og[hd];
            f32x4 v; v[0] = lo_bf(a.x) + lo_bf(b.x); v[1] = hi_bf(a.x) + hi_bf(b.x); v[2] = lo_bf(a.y) + lo_bf(b.y); v[3] = hi_bf(a.y) + hi_bf(b.y);
            float ss = v[0] * v[0] + v[1] * v[1] + v[2] * v[2] + v[3] * v[3];
            ss = wave_sum(ss);
            const float rstd = rsqrtf(ss * (1.0f / 256.0f) + EPS);
            f32x4 gt; gt[0] = lo_bf(gz.x); gt[1] = hi_bf(gz.x); gt[2] = lo_bf(gz.y); gt[3] = hi_bf(gz.y);
            f32x4 y;
            if (hd < 4) { for (int e = 0; e < 4; ++e) y[e] = v[e] * rstd * gg[e] * siluf_(gt[e]); }
            else { for (int e = 0; e < 4; ++e) y[e] = sigmoidf_(gt[e]) * (v[e] * rstd * gm[e]); }
            u32x2 w; w.x = cvt_pk_bf16(y[0], y[1]); w.y = cvt_pk_bf16(y[2], y[3]);
            *(u32x2*)(Y + (size_t)row * DM + col) = w;
        }
    }
}

__device__ __forceinline__ void phase_conv(const Params& p, int l, bool with_ctx, bool dry = false) {
    bf16_t* U = (bf16_t*)(p.ws + WS_UZ);
    const float* cw = p.conv_w + (size_t)l * 9 * DFF;
    const float* cb = p.conv_b + (size_t)l * DFF;
    const int tid = otid();
    constexpr int NFG = DFF / 4;
    const int n_lat = NB * 64 * 8 * NFG, n_ctx = with_ctx ? NB * 32 * NFG : 0;
    for (int item = blockIdx.x * 512 + tid; item < n_lat + n_ctx; item += gridDim.x * 512) {
        int fg, rowbase, ncols, c0, nrowsg, r;
        if (item < n_lat) { fg = item % NFG; const int rest = item / NFG; const int seg = rest & 7; r = (rest >> 3) & 63; const int b = rest >> 9; rowbase = b * TL; ncols = 64; nrowsg = 64; c0 = seg * 8; }
        else { const int it2 = item - n_lat; fg = it2 % NFG; const int rest = it2 / NFG; const int seg = rest & 31, b = rest >> 5; rowbase = RL + b * TC; ncols = 256; nrowsg = 1; r = 0; c0 = seg * 8; }
        const int f0 = fg * 4;
        u32x2 G[3][10];
        float rowok[3];
#pragma unroll
        for (int dy = 0; dy < 3; ++dy) {
            const int rr = r + dy - 1; const bool rok = rr >= 0 && rr < nrowsg; rowok[dy] = rok ? 1.0f : 0.0f;
            const int rrc = rr < 0 ? 0 : (rr >= nrowsg ? nrowsg - 1 : rr);
#pragma unroll
            for (int j = 0; j < 10; ++j) {
                const int cc = c0 + j - 1; const int ccc = cc < 0 ? 0 : (cc >= ncols ? ncols - 1 : cc);
                G[dy][j] = *(const u32x2*)(U + (size_t)(rowbase + rrc * ncols + ccc) * DFF2 + f0);
            }
        }
        const bool lok = c0 > 0, rok9 = c0 + 8 < ncols;
#pragma unroll
        for (int dy = 0; dy < 3; ++dy) { if (!lok) G[dy][0] = (u32x2){0u, 0u}; if (!rok9) G[dy][9] = (u32x2){0u, 0u}; }
        u32x2 V[8];
        bf16_t* vp = U + (size_t)(rowbase + r * ncols + c0) * DFF2 + DFF + f0;
#pragma unroll
        for (int t = 0; t < 8; ++t) V[t] = *(const u32x2*)(vp + (size_t)t * DFF2);
        typedef float f32x2 __attribute__((ext_vector_type(2)));
        f32x2 W01[3][3], W23[3][3];
#pragma unroll
        for (int dy = 0; dy < 3; ++dy)
#pragma unroll
            for (int dx = 0; dx < 3; ++dx) { const f32x4 w = *(const f32x4*)(cw + (size_t)(dy * 3 + dx) * DFF + f0) * rowok[dy]; W01[dy][dx] = (f32x2){w[0], w[1]}; W23[dy][dx] = (f32x2){w[2], w[3]}; }
        const f32x4 bias = *(const f32x4*)(cb + f0);
        f32x2 P01[3][10], P23[3][10];
#pragma unroll
        for (int dy = 0; dy < 3; ++dy)
#pragma unroll
            for (int j = 0; j < 10; ++j) { const u32x2 g = G[dy][j];
                P01[dy][j] = (f32x2){lo_bf(g.x), hi_bf(g.x)}; P23[dy][j] = (f32x2){lo_bf(g.y), hi_bf(g.y)}; }
#pragma unroll
        for (int t = 0; t < 8; ++t) {
            f32x2 a01 = (f32x2){bias[0], bias[1]}, a23 = (f32x2){bias[2], bias[3]};
#pragma unroll
            for (int dy = 0; dy < 3; ++dy)
#pragma unroll
                for (int dx = 0; dx < 3; ++dx) { a01 = P01[dy][t + dx] * W01[dy][dx] + a01; a23 = P23[dy][t + dx] * W23[dy][dx] + a23; }
            u32x2 o;
            o.x = cvt_pk_bf16(siluf_(a01[0]) * lo_bf(V[t].x), siluf_(a01[1]) * hi_bf(V[t].x));
            o.y = cvt_pk_bf16(siluf_(a23[0]) * lo_bf(V[t].y), siluf_(a23[1]) * hi_bf(V[t].y));
            if (!dry || o.x == 0x7fc17fc1u) *(u32x2*)(vp + (size_t)t * DFF2) = o;
        }
    }
}

constexpr int NCHUNK = RT / 64;
__device__ __forceinline__ void phase_decay(const Params& p, int l, LAS unsigned char* lds) {
    LAS float* W = (LAS float*)lds;
    LAS float* Bv = (LAS float*)(lds + 65536);
    const int tid = otid(), lane = tid & 63, wv = tid >> 6;
    __syncthreads();
    {
        f32x4 wv4[8];
        const f32x4* wsrc = (const f32x4*)(p.gla_w_lr + (size_t)l * 2 * 16 * 512);
#pragma unroll
        for (int q = 0; q < 8; ++q) wv4[q] = wsrc[q * 512 + tid];
        float bvv[2];
#pragma unroll
        for (int q = 0; q < 2; ++q) bvv[q] = p.gla_b_lr[(size_t)l * 2 * 512 + q * 512 + tid];
#pragma unroll
        for (int q = 0; q < 8; ++q) ((LAS f32x4*)W)[q * 512 + tid] = wv4[q];
#pragma unroll
        for (int q = 0; q < 2; ++q) Bv[q * 512 + tid] = bvv[q];
    }
    __syncthreads();
    const bf16_t* Z = (const bf16_t*)(p.ws + WS_Z);
    bf16_t* QAg = (bf16_t*)(p.ws + WS_A);
    bf16_t* KAg = QAg + (size_t)2 * RT * 512;
    float* EEND = (float*)(p.ws + WS_EEND);
    const float qk_scale = 0.08838834764831845f;
    bf16_t* MQg = (bf16_t*)(p.ws + WS_MQK);
    bf16_t* MKg = MQg + (size_t)RT * 512;
    float* GATES = (float*)(p.ws + WS_GATES);
    u32x4 pf[6]; bool pf_valid = false;
#pragma unroll
    for (int q = 0; q < 6; ++q) pf[q] = (u32x4){0u, 0u, 0u, 0u};
    for (int item = blockIdx.x * 8 + wv; item < NCHUNK * 2 * 32 + NCHUNK * 32; item += gridDim.x * 8) {
        if (item >= NCHUNK * 2 * 32) {
            const int it2 = item - NCHUNK * 2 * 32, cg = it2 & 31, chunk = it2 >> 5;
            const int row = chunk * 64 + lane;
            const bf16_t* zr = Z + (size_t)row * PWP;
            const u32x4 q0 = *(const u32x4*)(zr + ZC_MQ + cg * 16), q1 = *(const u32x4*)(zr + ZC_MQ + cg * 16 + 8);
            const u32x4 k0 = *(const u32x4*)(zr + ZC_MK + cg * 16), k1 = *(const u32x4*)(zr + ZC_MK + cg * 16 + 8);
            const unsigned kw[8] = {k0.x, k0.y, k0.z, k0.w, k1.x, k1.y, k1.z, k1.w};
            unsigned ks[8];
#pragma unroll
            for (int e = 0; e < 8; ++e) ks[e] = cvt_pk_bf16(lo_bf(kw[e]) * qk_scale, hi_bf(kw[e]) * qk_scale);
            u32x4* qd = (u32x4*)(MQg + ((size_t)chunk * 32 + cg) * 1024 + lane * 16);
            u32x4* kd = (u32x4*)(MKg + ((size_t)chunk * 32 + cg) * 1024 + lane * 16);
            qd[0] = q0; qd[1] = q1;
            kd[0] = (u32x4){ks[0], ks[1], ks[2], ks[3]}; kd[1] = (u32x4){ks[4], ks[5], ks[6], ks[7]};
            if ((cg & 7) == 0) {
                const int h = cg >> 3;
#pragma unroll
                for (int dir = 0; dir < 2; ++dir) {
                    const float bi = p.mlstm_b_gate[((l * 2 + dir) * 2 + 0) * 4 + h], bf = p.mlstm_b_gate[((l * 2 + dir) * 2 + 1) * 4 + h];
                    const int rowd = chunk * 64 + (dir ? 63 - lane : lane);
                    const bf16_t* zd = Z + (size_t)rowd * PWP;
                    const float logi = bf2f(zd[ZC_MG + dir * 8 + h]) + bi;
                    const float logf = logsigf_(bf2f(zd[ZC_MG + dir * 8 + 4 + h]) + bf);
                    const float fcum = wave_incl_sum(logf), av = logi - fcum, aj = wave_incl_max(av);
                    GATES[(size_t)((dir * 4 + h) * 3 + 0) * RT + rowd] = fcum;
                    GATES[(size_t)((dir * 4 + h) * 3 + 1) * RT + rowd] = av;
                    GATES[(size_t)((dir * 4 + h) * 3 + 2) * RT + rowd] = aj;
                }
            }
            continue;
        }
        const int cg = item & 31, dir = (item >> 5) & 1, chunk = item >> 6;
        if (!pf_valid) { const int row = chunk * 64 + (dir ? 63 - lane : lane); const bf16_t* zr = Z + (size_t)row * PWP;
            pf[0] = *(const u32x4*)(zr + ZC_LR); pf[1] = *(const u32x4*)(zr + ZC_LR + 8); pf[2] = *(const u32x4*)(zr + ZC_GQ + cg * 16); pf[3] = *(const u32x4*)(zr + ZC_GQ + cg * 16 + 8);
            pf[4] = *(const u32x4*)(zr + ZC_GK + cg * 16); pf[5] = *(const u32x4*)(zr + ZC_GK + cg * 16 + 8); }
        const u32x4 g0 = pf[0], g1 = pf[1], q0 = pf[2], q1 = pf[3], k0 = pf[4], k1 = pf[5];
        {
            const int nitem = item + (int)gridDim.x * 8;
            pf_valid = nitem < NCHUNK * 2 * 32;
            if (pf_valid) { const int ncg = nitem & 31, ndir = (nitem >> 5) & 1, nchunk = nitem >> 6; const int nrow = nchunk * 64 + (ndir ? 63 - lane : lane); const bf16_t* zn = Z + (size_t)nrow * PWP;
                pf[0] = *(const u32x4*)(zn + ZC_LR); pf[1] = *(const u32x4*)(zn + ZC_LR + 8); pf[2] = *(const u32x4*)(zn + ZC_GQ + ncg * 16); pf[3] = *(const u32x4*)(zn + ZC_GQ + ncg * 16 + 8);
                pf[4] = *(const u32x4*)(zn + ZC_GK + ncg * 16); pf[5] = *(const u32x4*)(zn + ZC_GK + ncg * 16 + 8); }
        }
        const unsigned gw[8] = {g0.x, g0.y, g0.z, g0.w, g1.x, g1.y, g1.z, g1.w};
        const unsigned qw[8] = {q0.x, q0.y, q0.z, q0.w, q1.x, q1.y, q1.z, q1.w};
        const unsigned kw[8] = {k0.x, k0.y, k0.z, k0.w, k1.x, k1.y, k1.z, k1.w};
        float gl[16];
#pragma unroll
        for (int e = 0; e < 8; ++e) { gl[2 * e] = lo_bf(gw[e]); gl[2 * e + 1] = hi_bf(gw[e]); }
        unsigned qaw[8], kaw[8]; float eesel = 0.f;
#pragma unroll
        for (int c4 = 0; c4 < 4; ++c4) {
            const int ch0 = cg * 16 + c4 * 4;
            f32x4 dec = *(const LAS f32x4*)(Bv + dir * 512 + ch0);
#pragma unroll
            for (int r = 0; r < 16; ++r) dec += gl[r] * *(const LAS f32x4*)(W + (dir * 16 + r) * 512 + ch0);
            float qa[4], ka[4], la4[4];
#pragma unroll
            for (int e = 0; e < 4; ++e) la4[e] = logsigf_(dec[e]) * (1.0f / 16.0f);
#pragma unroll
            for (int e = 0; e < 4; ++e) la4[e] += dpp_f<0x111, 0xF>(la4[e], 0.f);
#pragma unroll
            for (int e = 0; e < 4; ++e) la4[e] += dpp_f<0x112, 0xF>(la4[e], 0.f);
#pragma unroll
            for (int e = 0; e < 4; ++e) la4[e] += dpp_f<0x114, 0xF>(la4[e], 0.f);
#pragma unroll
            for (int e = 0; e < 4; ++e) la4[e] += dpp_f<0x118, 0xF>(la4[e], 0.f);
#pragma unroll
            for (int e = 0; e < 4; ++e) la4[e] += dpp_f<0x142, 0xA>(la4[e], 0.f);
#pragma unroll
            for (int e = 0; e < 4; ++e) la4[e] += dpp_f<0x143, 0xC>(la4[e], 0.f);
#pragma unroll
            for (int e = 0; e < 4; ++e) {
                const int cc = c4 * 4 + e;
                const float la = la4[e];
                const float ev = __expf(la), eend = rdlane63(ev), rc = __builtin_amdgcn_rcpf(ev);
                const float qv = (cc & 1) ? hi_bf(qw[cc >> 1]) : lo_bf(qw[cc >> 1]);
                const float kv = (cc & 1) ? hi_bf(kw[cc >> 1]) : lo_bf(kw[cc >> 1]);
                qa[e] = qv * ev * qk_scale; ka[e] = kv * rc;
                eesel = (lane == cc) ? eend : eesel;
            }
            qaw[c4 * 2] = cvt_pk_bf16(qa[0], qa[1]); qaw[c4 * 2 + 1] = cvt_pk_bf16(qa[2], qa[3]);
            kaw[c4 * 2] = cvt_pk_bf16(ka[0], ka[1]); kaw[c4 * 2 + 1] = cvt_pk_bf16(ka[2], ka[3]);
        }
        u32x4* qd = (u32x4*)(QAg + (((size_t)dir * NCHUNK + chunk) * 32 + cg) * 1024 + lane * 16);
        u32x4* kd = (u32x4*)(KAg + (((size_t)dir * NCHUNK + chunk) * 32 + cg) * 1024 + lane * 16);
        qd[0] = (u32x4){qaw[0], qaw[1], qaw[2], qaw[3]}; qd[1] = (u32x4){qaw[4], qaw[5], qaw[6], qaw[7]};
        kd[0] = (u32x4){kaw[0], kaw[1], kaw[2], kaw[3]}; kd[1] = (u32x4){kaw[4], kaw[5], kaw[6], kaw[7]};
        if (lane < 16) EEND[((size_t)dir * NCHUNK + chunk) * 512 + cg * 16 + lane] = eesel;
    }
}

constexpr int SC_QA = 0, SC_KA = 17408, SC_KE = 34816, SC_VT = 53248  , SC_PP = 71680  , SC_ST = 90112, SC_AV = 108064, SC_MJ = 108320, SC_INTER = 108576, SC_MQ = 108832, SC_END = 109088;
constexpr int SC_VTB = 9216, SC_PPB = 9216;
constexpr int LD_QK = 136, LD_T = 72;
static_assert(SC_END <= LDS_BYTES, "scan lds");

__device__ __forceinline__ bf16x8 lds_frag(const LAS unsigned char* base, int row, int ld_elems, int kk, int fq) {
    return *(const LAS bf16x8*)(base + (size_t)(row * ld_elems + fq * 8 + kk * 32) * 2);
}
struct ScanIn { u32x4 q0, q1, k0, k1, vv; f32x4 ee; float gi, gf, ga; };

__device__ __forceinline__ void phase_scan(const Params& p, int l, LAS unsigned char* lds) {
    const bf16_t* Z = (const bf16_t*)(p.ws + WS_Z);
    const bf16_t* QAg = (const bf16_t*)(p.ws + WS_A);
    const bf16_t* KAg = QAg + (size_t)2 * RT * 512;
    const float* EEND = (const float*)(p.ws + WS_EEND);
    const bf16_t* MQg = (const bf16_t*)(p.ws + WS_MQK);
    const bf16_t* MKg = MQg + (size_t)RT * 512;
    const float* GATES = (const float*)(p.ws + WS_GATES);
    bf16_t* Obuf = (bf16_t*)(p.ws + WS_O);
    int tid = threadIdx.x; asm volatile("" : "+v"(tid));
    const int lane = tid & 63, wv = __builtin_amdgcn_readfirstlane(tid >> 6), fr = lane & 15, fq = lane >> 4;
    LAS bf16_t* QA = (LAS bf16_t*)(lds + SC_QA); LAS bf16_t* KA = (LAS bf16_t*)(lds + SC_KA); LAS bf16_t* KE = (LAS bf16_t*)(lds + SC_KE);
    LAS bf16_t* VT = (LAS bf16_t*)(lds + SC_VT); LAS bf16_t* PP = (LAS bf16_t*)(lds + SC_PP); LAS bf16_t* ST = (LAS bf16_t*)(lds + SC_ST);
    LAS float* AV = (LAS float*)(lds + SC_AV); LAS float* MJ = (LAS float*)(lds + SC_MJ); LAS float* INTER = (LAS float*)(lds + SC_INTER); LAS float* MQ = (LAS float*)(lds + SC_MQ);
    const LAS unsigned char* QAb = (const LAS unsigned char*)QA; const LAS unsigned char* KAb = (const LAS unsigned char*)KA; const LAS unsigned char* KEb = (const LAS unsigned char*)KE;
    const LAS unsigned char* VTb = (const LAS unsigned char*)VT; const LAS unsigned char* PPb = (const LAS unsigned char*)PP; const LAS unsigned char* STb = (const LAS unsigned char*)ST;
    const float qk_scale = 0.08838834764831845f;
    const short one_or_zero = (fr == 0) ? (short)0x3F80 : (short)0;
    const bf16x8 ones_frag = {one_or_zero, one_or_zero, one_or_zero, one_or_zero, one_or_zero, one_or_zero, one_or_zero, one_or_zero};
    const bf16x8 zero_frag = {0, 0, 0, 0, 0, 0, 0, 0};

    for (int item = blockIdx.x; item < 256; item += gridDim.x) {
        const int grp = item & 1, dir = (item >> 1) & 1, dvq = (item >> 2) & 3, h = (item >> 4) & 3, b = (item >> 6) & 3;
        __syncthreads();
        for (int i = tid; i < 66 * LD_QK / 2; i += 512) ((LAS unsigned*)ST)[i] = 0u;
        float bg_i = 0.f, bg_f = 0.f;
        if (grp == 1) { bg_i = p.mlstm_b_gate[((l * 2 + dir) * 2 + 0) * 4 + h]; bg_f = p.mlstm_b_gate[((l * 2 + dir) * 2 + 1) * 4 + h]; }
        f32x4 S[4], S5 = {0.f, 0.f, 0.f, 0.f};
#pragma unroll
        for (int q4 = 0; q4 < 4; ++q4) S[q4] = (f32x4){0.f, 0.f, 0.f, 0.f};
        float m_run = 0.f;
        const int qcol = ZC_MQ + h * 128 + wv * 16, kcol = ZC_MK + h * 128 + wv * 16;
        const int gqcol = h * 128 + wv * 16;
        const int vcol = (grp == 0 ? ZC_GV : ZC_MV) + h * 256 + dvq * 64 + wv * 8;
        const int ocol = grp * 1024 + h * 256 + dvq * 64;
        const int gcol_i = ZC_MG + dir * 8 + h, gcol_f = ZC_MG + dir * 8 + 4 + h;
        __syncthreads();

        auto load_step = [&](int s) -> ScanIn {
            ScanIn in;
            const bool is_ctx = s < 4;
            const int cch = is_ctx ? s : s - 4;
            const int nch = is_ctx ? (TC / 64) : (TL / 64);
            const int rowbase = is_ctx ? (RL + b * TC) : (b * TL);
            const int mc = dir ? (nch - 1 - cch) : cch;
            const int row = rowbase + mc * 64 + (dir ? 63 - lane : lane);
            const bf16_t* zr = Z + (size_t)row * PWP;
            in.vv = *(const u32x4*)(zr + vcol);
            in.gi = GATES[(size_t)((dir * 4 + h) * 3 + 0) * RT + row]; in.gf = GATES[(size_t)((dir * 4 + h) * 3 + 1) * RT + row]; in.ga = GATES[(size_t)((dir * 4 + h) * 3 + 2) * RT + row];
            const int gchunk = (rowbase >> 6) + mc;
            if (grp == 0) {
                const bf16_t* qr = QAg + (((size_t)dir * NCHUNK + gchunk) * 32 + h * 8 + wv) * 1024 + lane * 16;
                const bf16_t* kr = KAg + (((size_t)dir * NCHUNK + gchunk) * 32 + h * 8 + wv) * 1024 + lane * 16;
                in.q0 = *(const u32x4*)(qr); in.q1 = *(const u32x4*)(qr + 8);
                in.k0 = *(const u32x4*)(kr); in.k1 = *(const u32x4*)(kr + 8);
                in.ee = *(const f32x4*)(EEND + ((size_t)dir * NCHUNK + gchunk) * 512 + gqcol + fq * 4);
            } else {
                const int tm = dir ? 63 - lane : lane;
                const bf16_t* qr = MQg + ((size_t)gchunk * 32 + h * 8 + wv) * 1024 + tm * 16;
                const bf16_t* kr = MKg + ((size_t)gchunk * 32 + h * 8 + wv) * 1024 + tm * 16;
                in.q0 = *(const u32x4*)(qr); in.q1 = *(const u32x4*)(qr + 8);
                in.k0 = *(const u32x4*)(kr); in.k1 = *(const u32x4*)(kr + 8);
                in.ee = (f32x4){1.f, 1.f, 1.f, 1.f};
            }
            return in;
        };

        ScanIn cur = load_step(0);
        for (int s = 0; s < 68; ++s) {
            const bool is_ctx = s < 4;
            const int cch = is_ctx ? s : s - 4;
            const int nch = is_ctx ? (TC / 64) : (TL / 64);
            const int rowbase = is_ctx ? (RL + b * TC) : (b * TL);
            const int mc = dir ? (nch - 1 - cch) : cch;
            const bool want_out = (!is_ctx) || (l == 0);
            const int par = s & 1;
            LAS bf16_t* VTp = VT + par * (SC_VTB / 2); LAS bf16_t* PPp = PP + par * (SC_PPB / 2);
            const LAS unsigned char* VTpb = VTb + par * SC_VTB; const LAS unsigned char* PPpb = PPb + par * SC_PPB;
            const unsigned qw[8] = {cur.q0.x, cur.q0.y, cur.q0.z, cur.q0.w, cur.q1.x, cur.q1.y, cur.q1.z, cur.q1.w};
            const unsigned kw[8] = {cur.k0.x, cur.k0.y, cur.k0.z, cur.k0.w, cur.k1.x, cur.k1.y, cur.k1.z, cur.k1.w};
            float m_new = 0.f, cs = 1.f;
            unsigned kaw[8];
            if (grp == 0) {
#pragma unroll
                for (int e = 0; e < 8; ++e) {
                    const int ch = wv * 16 + 2 * e;
                    kaw[e] = kw[e];
                    KE[ch * LD_T + lane] = (bf16_t)(kw[e] & 0xffffu);
                    KE[(ch + 1) * LD_T + lane] = (bf16_t)(kw[e] >> 16);
                }
            } else {
                const float fcum = cur.gi, av = cur.gf, Aj = cur.ga;
                const float fend = rdlane63(fcum);
                const float amax = rdlane63(Aj);
                m_new = fmaxf(fend + m_run, fend + amax);
                cs = __expf(fend + m_run - m_new);
                const float wi = __expf(fend + av - m_new);
                const float Mj = fmaxf(m_run, Aj);
                if (wv == 0) { AV[lane] = av; MJ[lane] = Mj; INTER[lane] = __expf(m_run - Mj); MQ[lane] = fcum + Mj; }
#pragma unroll
                for (int e = 0; e < 8; ++e) {
                    const float k_lo = lo_bf(kw[e]), k_hi = hi_bf(kw[e]);
                    const int ch = wv * 16 + 2 * e;
                    kaw[e] = kw[e];
                    const unsigned ke = cvt_pk_bf16(wi * k_lo, wi * k_hi);
                    KE[ch * LD_T + lane] = (bf16_t)(ke & 0xffffu);
                    KE[(ch + 1) * LD_T + lane] = (bf16_t)(ke >> 16);
                }
            }
            { LAS u32x4* qd = (LAS u32x4*)(QA + lane * LD_QK + wv * 16); qd[0] = cur.q0; qd[1] = cur.q1;
              LAS u32x4* kd = (LAS u32x4*)(KA + lane * LD_QK + wv * 16); kd[0] = (u32x4){kaw[0], kaw[1], kaw[2], kaw[3]}; kd[1] = (u32x4){kaw[4], kaw[5], kaw[6], kaw[7]}; }
            { const unsigned vw[4] = {cur.vv.x, cur.vv.y, cur.vv.z, cur.vv.w};
#pragma unroll
              for (int e = 0; e < 4; ++e) { VTp[(wv * 8 + 2 * e) * LD_T + lane] = (bf16_t)(vw[e] & 0xffffu); VTp[(wv * 8 + 2 * e + 1) * LD_T + lane] = (bf16_t)(vw[e] >> 16); } }
            f32x4 ee_now = cur.ee;
            asm volatile("" : "+v"(ee_now));
            __syncthreads();
            __builtin_amdgcn_s_waitcnt(0x0F70);
            ScanIn nxt = load_step(s + 1 < 68 ? s + 1 : s);
            const int tj_o = wv & 3, j_o = tj_o * 16 + fr;
            f32x4 a2[2] = {{0.f, 0.f, 0.f, 0.f}, {0.f, 0.f, 0.f, 0.f}}, d2 = {0.f, 0.f, 0.f, 0.f};
            float rs = 1.f, emq = 0.f;
            const bf16x8 ak0 = lds_frag(KEb, wv * 16 + fr, LD_T, 0, fq), ak1 = lds_frag(KEb, wv * 16 + fr, LD_T, 1, fq);
            if (want_out) {
                const int t0 = wv * 2, tja = t0 >> 2, ti0 = t0 & 3, ti1 = ti0 + 1;
                const bool on0 = ti0 <= tja, on1 = ti1 <= tja;
                bf16x8 fq_[4], fk0[4], fk1[4];
#pragma unroll
                for (int kk = 0; kk < 4; ++kk) { fq_[kk] = lds_frag(QAb, tja * 16 + fr, LD_QK, kk, fq); fk0[kk] = lds_frag(KAb, ti0 * 16 + fr, LD_QK, kk, fq); fk1[kk] = lds_frag(KAb, ti1 * 16 + fr, LD_QK, kk, fq); }
                bf16x8 bq[4], fs0[4], fs1[4];
                const int tv0 = (wv >> 2) * 2;
#pragma unroll
                for (int kk = 0; kk < 4; ++kk) { bq[kk] = lds_frag(QAb, j_o, LD_QK, kk, fq); fs0[kk] = lds_frag(STb, tv0 * 16 + fr, LD_QK, kk, fq); fs1[kk] = lds_frag(STb, (tv0 + 1) * 16 + fr, LD_QK, kk, fq); }
                __builtin_amdgcn_sched_barrier(0);
                f32x4 acc0 = {0.f, 0.f, 0.f, 0.f}, acc1 = {0.f, 0.f, 0.f, 0.f};
                if (on0) {
#pragma unroll
                    for (int kk = 0; kk < 4; ++kk) acc0 = __builtin_amdgcn_mfma_f32_16x16x32_bf16(fk0[kk], fq_[kk], acc0, 0, 0, 0);
                }
                if (on1) {
#pragma unroll
                    for (int kk = 0; kk < 4; ++kk) acc1 = __builtin_amdgcn_mfma_f32_16x16x32_bf16(fk1[kk], fq_[kk], acc1, 0, 0, 0);
                }
                {
                    f32x4 a = {0.f, 0.f, 0.f, 0.f}, b = {0.f, 0.f, 0.f, 0.f};
#pragma unroll
                    for (int kk = 0; kk < 4; ++kk) { a = __builtin_amdgcn_mfma_f32_16x16x32_bf16(fs0[kk], bq[kk], a, 0, 0, 0); b = __builtin_amdgcn_mfma_f32_16x16x32_bf16(fs1[kk], bq[kk], b, 0, 0, 0); }
                    a2[0] = a; a2[1] = b;
                }
                if (grp == 1) {
                    bf16x8 n0 = lds_frag(STb, 64, LD_QK, 0, fq), n1 = lds_frag(STb, 64, LD_QK, 1, fq), n2 = lds_frag(STb, 64, LD_QK, 2, fq), n3 = lds_frag(STb, 64, LD_QK, 3, fq);
                    if (fr != 0) { n0 = zero_frag; n1 = zero_frag; n2 = zero_frag; n3 = zero_frag; }
                    d2 = __builtin_amdgcn_mfma_f32_16x16x32_bf16(n0, bq[0], d2, 0, 0, 0);
                    d2 = __builtin_amdgcn_mfma_f32_16x16x32_bf16(n1, bq[1], d2, 0, 0, 0);
                    d2 = __builtin_amdgcn_mfma_f32_16x16x32_bf16(n2, bq[2], d2, 0, 0, 0);
                    d2 = __builtin_amdgcn_mfma_f32_16x16x32_bf16(n3, bq[3], d2, 0, 0, 0);
                    rs = INTER[j_o]; emq = __expf(-MQ[j_o]);
                }
                {
                    const int j = tja * 16 + fr;
#pragma unroll
                    for (int tt = 0; tt < 2; ++tt) {
                        const int i0 = (ti0 + tt) * 16 + fq * 4; const f32x4 acc = tt ? acc1 : acc0;
                        float vals[4];
                        if (grp == 1) {
                            const f32x4 av4 = *(const LAS f32x4*)(AV + i0); const float mj = MJ[j];
#pragma unroll
                            for (int r = 0; r < 4; ++r) vals[r] = (i0 + r <= j) ? acc[r] * __expf(av4[r] - mj) : 0.f;
                        } else {
#pragma unroll
                            for (int r = 0; r < 4; ++r) vals[r] = (i0 + r <= j) ? acc[r] : 0.f;
                        }
                        u32x2 w; w.x = cvt_pk_bf16(vals[0], vals[1]); w.y = cvt_pk_bf16(vals[2], vals[3]);
                        *(LAS u32x2*)(PPp + j * LD_T + i0) = w;
                    }
                }
            }
            {
                bf16x8 fv[4][2];
#pragma unroll
                for (int tv = 0; tv < 4; ++tv) { fv[tv][0] = lds_frag(VTpb, tv * 16 + fr, LD_T, 0, fq); fv[tv][1] = lds_frag(VTpb, tv * 16 + fr, LD_T, 1, fq); }
                __builtin_amdgcn_sched_barrier(0);
#pragma unroll
                for (int tv = 0; tv < 4; ++tv) {
                    f32x4 a = S[tv] * cs;
                    a = __builtin_amdgcn_mfma_f32_16x16x32_bf16(ak0, fv[tv][0], a, 0, 0, 0);
                    a = __builtin_amdgcn_mfma_f32_16x16x32_bf16(ak1, fv[tv][1], a, 0, 0, 0);
                    S[tv] = a * ee_now;
                }
                if (grp == 1) {
                    f32x4 a = S5 * cs;
                    a = __builtin_amdgcn_mfma_f32_16x16x32_bf16(ak0, ones_frag, a, 0, 0, 0);
                    a = __builtin_amdgcn_mfma_f32_16x16x32_bf16(ak1, ones_frag, a, 0, 0, 0);
                    S5 = a;
                }
            }
            __syncthreads();
            {
#pragma unroll
                for (int tv = 0; tv < 4; ++tv) { u32x2 w; w.x = cvt_pk_bf16(S[tv][0], S[tv][1]); w.y = cvt_pk_bf16(S[tv][2], S[tv][3]);
                    *(LAS u32x2*)(ST + (tv * 16 + fr) * LD_QK + wv * 16 + fq * 4) = w; }
                if (grp == 1 && fr == 0) { u32x2 w; w.x = cvt_pk_bf16(S5[0], S5[1]); w.y = cvt_pk_bf16(S5[2], S5[3]);
                    *(LAS u32x2*)(ST + 64 * LD_QK + wv * 16 + fq * 4) = w; }
            }
            if (want_out) {
                const bf16x8 bp0 = lds_frag(PPpb, j_o, LD_T, 0, fq), bp1 = lds_frag(PPpb, j_o, LD_T, 1, fq);
                bf16x8 fvb[2][2];
#pragma unroll
                for (int tt = 0; tt < 2; ++tt) { const int tv = (wv >> 2) * 2 + tt; fvb[tt][0] = lds_frag(VTpb, tv * 16 + fr, LD_T, 0, fq); fvb[tt][1] = lds_frag(VTpb, tv * 16 + fr, LD_T, 1, fq); }
                __builtin_amdgcn_sched_barrier(0);
                float dn = 1.f;
                if (grp == 1) {
                    f32x4 d1 = {0.f, 0.f, 0.f, 0.f};
                    d1 = __builtin_amdgcn_mfma_f32_16x16x32_bf16(ones_frag, bp0, d1, 0, 0, 0);
                    d1 = __builtin_amdgcn_mfma_f32_16x16x32_bf16(ones_frag, bp1, d1, 0, 0, 0);
                    float den = d1[0] + rs * d2[0];
                    den = __int_as_float(__builtin_amdgcn_ds_bpermute(fr << 2, __float_as_int(den)));
                    dn = __builtin_amdgcn_rcpf(fmaxf(fabsf(den), emq));
                }
                const int rowj = rowbase + mc * 64 + (dir ? 63 - j_o : j_o);
#pragma unroll
                for (int tt = 0; tt < 2; ++tt) {
                    const int tv = (wv >> 2) * 2 + tt;
                    f32x4 a1 = {0.f, 0.f, 0.f, 0.f};
                    a1 = __builtin_amdgcn_mfma_f32_16x16x32_bf16(fvb[tt][0], bp0, a1, 0, 0, 0);
                    a1 = __builtin_amdgcn_mfma_f32_16x16x32_bf16(fvb[tt][1], bp1, a1, 0, 0, 0);
                    const f32x4 o = (a1 + rs * a2[tt]) * dn;
                    u32x2 w; w.x = cvt_pk_bf16(o[0], o[1]); w.y = cvt_pk_bf16(o[2], o[3]);
                    *(u32x2*)(Obuf + (size_t)dir * RT * DM + (size_t)rowj * DM + ocol + tv * 16 + fq * 4) = w;
                }
            }
            m_run = m_new;
            cur = nxt;
        }
    }
}

__global__ void __launch_bounds__(512, 2) mk_fwd(Params p) {
    extern __shared__ __attribute__((aligned(16))) unsigned char lds_raw[];
    LAS unsigned char* lds = (LAS unsigned char*)lds_raw;
    float* XB = (float*)(p.ws + WS_X);
    bf16_t* AB = (bf16_t*)(p.ws + WS_A);
    const float* MOD = (const float*)(p.ws + WS_MOD);
    int ph = 0;
    const int lo = (int)p.ph_lo, hi = (int)p.ph_hi;
#if !MULTI_LAUNCH
    if (lo < 0) cg::this_grid().sync();
    if (threadIdx.x < 4) ((LAS unsigned*)(lds + pg8::STAGE_BYTES))[threadIdx.x] = 0u;
    __syncthreads();
    const XcdBarrier gbar = xcd_barrier_post((unsigned*)(p.ws + WS_BAR), (volatile LAS unsigned*)(lds + pg8::STAGE_BYTES));
#endif
#define PHASE_BEGIN if (ph >= lo && ph < hi) {
#if MULTI_LAUNCH
#define PHASE_END } ++ph;
#else
#define PHASE_END } ++ph; if (ph > lo && ph < hi) xcd_barrier(gbar);
#endif
    PHASE_BEGIN
        for (int rep = 0; rep < REP_MISC; ++rep) { phase_mod(p, lds);
        __syncthreads(); }
        phase_wconv(p, 0, lds, 0, WC_T_IN, 0);
        phase_wconv(p, 0, lds, WC_T_IN + WC_TAIL0, WC_TOT, 0);
    PHASE_END
    for (int l = 0; l < NLAYER; ++l) {
        const float* modl = MOD + (size_t)l * 5 * MODW;
        const float* xl = l == 0 ? p.x : XB;
        const float* xc = l == 0 ? p.ctx : XB + (size_t)RL * DM;
        const int Mrows = l == 0 ? RT : RL;
        PHASE_BEGIN
            phase_norm(xl, xc, p.g_norm1 + l * DM, modl, 0, DM, RT, AB, l > 0 ? (const float*)(p.ws + WS_PART) : nullptr, XB + (size_t)RL * DM);
        PHASE_END
        PHASE_BEGIN
            pg8::Gemm g{AB, (const bf16_t*)(p.ws + WS_WIN), RT, PWP, DM, DM};
            pg8::StaticOrder S; S.init(RT, PWP, gridDim.x, blockIdx.x, DM);
            pg8::EpiBf16 E{(bf16_t*)(p.ws + WS_Z), PWP};
            for (int rep = 0; rep < REP_GEMM; ++rep) pg8::gemm_phase(lds, g, S, E);
            {
                const int nwg = (RT / 256) * (PWP / 256), extra = nwg % (int)gridDim.x;
                __syncthreads();
                if (l == 0) phase_wconv(p, 0, lds, WC_T_IN, WC_T_IN + WC_TAIL0, extra);
                else phase_wconv(p, l, lds, WC_NODN, WC_TOT, extra);
            }
        PHASE_END
        PHASE_BEGIN
#ifdef PROBE_CONV
            phase_decay(p, l, lds);
#endif
            phase_decay(p, l, lds);
        PHASE_END
        PHASE_BEGIN
            for (int rep = 0; rep < REP_SCAN; ++rep) phase_scan(p, l, lds);
        PHASE_END
        PHASE_BEGIN
            phase_merge(p, l, Mrows);
            if (l == 0) {
                const f32x4* src = (const f32x4*)p.ctx; f32x4* dst = (f32x4*)(XB + (size_t)RL * DM);
                for (int i = blockIdx.x * 512 + otid(); i < RC * DM / 4; i += gridDim.x * 512) dst[i] = src[i];
            }
        PHASE_END
        PHASE_BEGIN
            pg8::Gemm g{AB, (const bf16_t*)(p.ws + WS_WOUT), Mrows, DM, DM, DM};
            pg8::SplitTailOrder S; S.init(DM, gridDim.x, blockIdx.x, DM, l == 0);
            pg8::EpiRes E{xl, xc, XB, modl, 2 * DM, 1.0f, DM / 64, (float*)(p.ws + WS_PART)};
#ifdef PROBE_RES
            { pg8::EpiRes E0{xl, xc, XB, modl, 2 * DM, 0.0f, DM / 64, (float*)(p.ws + WS_PART)}; pg8::gemm_phase(lds, g, S, E0); }
#endif
            pg8::gemm_phase(lds, g, S, E);
        PHASE_END
        PHASE_BEGIN
            phase_norm(XB, XB + (size_t)RL * DM, p.g_norm2 + l * DM, modl, 3 * DM, 4 * DM, Mrows, AB, l == 0 ? (const float*)(p.ws + WS_PART) : nullptr, XB + (size_t)RL * DM);
        PHASE_END
        PHASE_BEGIN
            pg8::Gemm g{AB, (const bf16_t*)(p.ws + WS_WUP), Mrows, DFF2, DM, DM};
            pg8::StaticOrder S; S.init(Mrows, DFF2, gridDim.x, blockIdx.x, DM);
            pg8::EpiBf16 E{(bf16_t*)(p.ws + WS_UZ), DFF2};
            for (int rep = 0; rep < REP_GEMM; ++rep) pg8::gemm_phase(lds, g, S, E);
            if (l + 1 < NLAYER) {
                const int nwg = (Mrows / 256) * (DFF2 / 256), extra = nwg % (int)gridDim.x;
                __syncthreads();
                if (extra > 0) phase_wconv(p, l + 1, lds, 0, WC_T_IN + WC_T_OUT, extra);
                else phase_wconv(p, l + 1, lds, 0, WC_T_IN + WC_T_OUT, 0);
            }
        PHASE_END
        PHASE_BEGIN
#ifdef PROBE_CONV
            phase_conv(p, l, l == 0, true);
#endif
            phase_conv(p, l, l == 0);
        PHASE_END
        PHASE_BEGIN
            pg8::Gemm g{(const bf16_t*)(p.ws + WS_UZ) + DFF, (const bf16_t*)(p.ws + WS_WDN), Mrows, DM, DFF, DFF2};
            pg8::SplitTailOrder S; S.init(DM, gridDim.x, blockIdx.x, DFF, l == 0);
            pg8::EpiRes E{XB, XB + (size_t)RL * DM, XB, modl, 5 * DM, 1.0f, DFF / 64, (float*)(p.ws + WS_PART)};
#ifdef PROBE_RES
            { pg8::EpiRes E0{XB, XB + (size_t)RL * DM, XB, modl, 5 * DM, 0.0f, DFF / 64, (float*)(p.ws + WS_PART)}; pg8::gemm_phase(lds, g, S, E0); }
#endif
            pg8::gemm_phase(lds, g, S, E);
            if (l + 1 < NLAYER) {
                __syncthreads();
                phase_wconv(p, l + 1, lds, WC_T_IN + WC_T_OUT, WC_NODN, 0);
            }
        PHASE_END
    }
#ifdef EXTRA_SYNCS
    for (int i = 0; i < EXTRA_SYNCS; ++i) xcd_barrier(gbar);
#endif
    PHASE_BEGIN
        phase_final_norm(XB, p.g_final, p.out);
    PHASE_END
}
constexpr int N_PHASES = 1 + NLAYER * 10 + 1;

extern "C" void kernel_launch(void* const* d_in, const int* in_sizes, int n_in, void* d_out, int out_size, void* d_ws, size_t ws_size, hipStream_t stream) {
    static int grid = 0;
    if (grid == 0) {
        if (n_in != 20 || ws_size < WS_END) { fprintf(stderr, "kernel_launch: unexpected n_in %d or ws_size %zu (< %zu)\n", n_in, ws_size, (size_t)WS_END); grid = -1; return; }
        int dev = 0, cus = 0, per_cu = 0;
        hipGetDevice(&dev);
        hipDeviceGetAttribute(&cus, hipDeviceAttributeMultiprocessorCount, dev);
        if (hipFuncSetAttribute((const void*)mk_fwd, hipFuncAttributeMaxDynamicSharedMemorySize, LDS_BYTES) != hipSuccess) { fprintf(stderr, "kernel_launch: hipFuncSetAttribute failed\n"); grid = -1; return; }
        if (hipOccupancyMaxActiveBlocksPerMultiprocessor(&per_cu, (const void*)mk_fwd, 512, LDS_BYTES) != hipSuccess || per_cu < 1) { fprintf(stderr, "kernel_launch: occupancy query says %d\n", per_cu); per_cu = 1; }
        (void)hipGetLastError();
        grid = cus * 1;
        fprintf(stderr, "kernel_launch: cus %d per_cu %d grid %d ws %zu need %zu\n", cus, per_cu, grid, ws_size, (size_t)WS_END);
    }
    if (grid < 0) return;
    Params p{};
    const float** pp = (const float**)&p;
    for (int i = 0; i < 20; ++i) pp[i] = (const float*)d_in[i];
    p.out = (float*)d_out; p.ws = (unsigned char*)d_ws;
#if MULTI_LAUNCH
    for (int ph = 0; ph < N_PHASES; ++ph) {
        p.ph_lo = ph; p.ph_hi = ph + 1;
        hipLaunchKernelGGL(mk_fwd, dim3(grid), dim3(512), LDS_BYTES, stream, p);
    }
#else
    p.ph_lo = 0; p.ph_hi = N_PHASES;
    if (hipMemsetAsync((char*)d_ws + WS_BAR, 0, 16384, stream) != hipSuccess) { fprintf(stderr, "kernel_launch: memset of the barrier words failed\n"); return; }
    void* args[] = {&p};
    hipError_t e = hipLaunchCooperativeKernel((const void*)mk_fwd, dim3(grid), dim3(512), args, LDS_BYTES, stream);
    if (e != hipSuccess) fprintf(stderr, "cooperative launch failed: %s (grid %d)\n", hipGetErrorString(e), grid);
#endif
}
```
